# Optimizing an MI355X kernel written in HIP

```python
import math
import jax
import jax.numpy as jnp
from jax import lax
import numpy as np

D_MODEL = 1024
BATCH = 32
SEQ = 2048
DEPTH = 4

N_A_LAYERS = max(1, DEPTH // 2)
N_B_LAYERS = DEPTH - N_A_LAYERS

SSM_GROUP = 16
SSM_GROUPS = D_MODEL // SSM_GROUP
SSM_STATE = 64
STEP_MIN = 1e-3
STEP_MAX = 1e-1

N_HEADS = 16
QK_NOPE_DIM = 64
QK_ROPE_DIM = 32
QK_DIM = QK_NOPE_DIM + QK_ROPE_DIM
V_DIM = 64
Q_LORA_RANK = 384
KV_LORA_RANK = 256
ROPE_THETA = 10000.0
Q_BLOCK = 128

D_FF = -(-8 * D_MODEL // (3 * 256)) * 256

EPS = 1e-6
NEG_INF = -1e30

kernel_name = 'yoco_s5_mla_hybrid'


def rms_norm(x, gain):
    xf = x.astype(jnp.float32)
    y = xf * lax.rsqrt(jnp.mean(xf * xf, axis=-1, keepdims=True) + EPS)
    return (y * gain.astype(jnp.float32)).astype(x.dtype)


def swiglu_ffn(h, w_gate_up, w_down):
    gate, up = jnp.split(h @ w_gate_up, 2, axis=-1)
    return (jax.nn.silu(gate) * up) @ w_down


def cmul(ar, ai, br, bi):
    return ar * br - ai * bi, ar * bi + ai * br


def s5_mixer(h, w_in, lam_re, lam_im, log_step, b_re, b_im, c_re, c_im, d_skip, w_glu):
    bsz, seq, _ = h.shape
    f32 = jnp.float32
    u = (h @ w_in).reshape(bsz, seq, SSM_GROUPS, SSM_GROUP).astype(f32)
    step = jnp.exp(log_step.astype(f32))[:, None]
    lr, li = lam_re.astype(f32), lam_im.astype(f32)
    decay = jnp.exp(lr * step)
    a_re, a_im = decay * jnp.cos(li * step), decay * jnp.sin(li * step)
    den = lr * lr + li * li
    f_re = ((a_re - 1.0) * lr + a_im * li) / den
    f_im = (a_im * lr - (a_re - 1.0) * li) / den
    br, bi = cmul(f_re[..., None], f_im[..., None], b_re.astype(f32), b_im.astype(f32))
    cr, ci = c_re.astype(f32), c_im.astype(f32)

    def combine(e_i, e_j):
        ar_i, ai_i, xr_i, xi_i = e_i
        ar_j, ai_j, xr_j, xi_j = e_j
        ar, ai = cmul(ar_j, ai_j, ar_i, ai_i)
        xr, xi = cmul(ar_j, ai_j, xr_i, xi_i)
        return ar, ai, xr + xr_j, xi + xi_j

    def scan_sequence(u_seq):
        bu_re = jnp.einsum('gnk,lgk->lgn', br, u_seq)
        bu_im = jnp.einsum('gnk,lgk->lgn', bi, u_seq)
        ar_seq = jnp.broadcast_to(a_re, bu_re.shape)
        ai_seq = jnp.broadcast_to(a_im, bu_im.shape)
        _, _, xr, xi = lax.associative_scan(combine, (ar_seq, ai_seq, bu_re, bu_im), axis=0)
        return jnp.einsum('gkn,lgn->lgk', cr, xr) - jnp.einsum('gkn,lgn->lgk', ci, xi)

    y = lax.map(scan_sequence, u)
    y = y + d_skip.astype(f32).reshape(SSM_GROUPS, SSM_GROUP) * u
    z = jax.nn.gelu(y.reshape(bsz, seq, D_MODEL)).astype(h.dtype)
    val, gate = jnp.split(z @ w_glu, 2, axis=-1)
    return val * jax.nn.sigmoid(gate)


def rope_tables(positions):
    inv_freq = ROPE_THETA ** (-jnp.arange(0, QK_ROPE_DIM, 2, dtype=jnp.float32) / QK_ROPE_DIM)
    ang = positions.astype(jnp.float32)[..., None] * inv_freq
    return jnp.cos(ang), jnp.sin(ang)


def apply_rope(x, cos, sin):
    x1, x2 = jnp.split(x.astype(jnp.float32), 2, axis=-1)
    return jnp.concatenate([x1 * cos - x2 * sin, x1 * sin + x2 * cos], axis=-1).astype(x.dtype)


def mla_shared_kv(h, w_kv_a, kv_a_norm, w_kv_b, k_nope_norm, k_rope_norm, cos, sin):
    bsz, seq, _ = h.shape
    ckv = h @ w_kv_a
    c_kv = rms_norm(ckv[..., :KV_LORA_RANK], kv_a_norm)
    k_rope = apply_rope(rms_norm(ckv[..., KV_LORA_RANK:], k_rope_norm), cos, sin)
    kv = (c_kv @ w_kv_b).reshape(bsz, seq, N_HEADS, QK_NOPE_DIM + V_DIM)
    k_nope = rms_norm(kv[..., :QK_NOPE_DIM], k_nope_norm)
    v = kv[..., QK_NOPE_DIM:]
    k_rope = jnp.broadcast_to(k_rope[:, :, None, :], (bsz, seq, N_HEADS, QK_ROPE_DIM))
    k = jnp.concatenate([k_nope, k_rope], axis=-1)
    return k.transpose(0, 2, 1, 3), v.transpose(0, 2, 1, 3)


def mla_queries(h, w_q_a, q_a_norm, w_q_b, q_nope_norm, q_rope_norm, cos, sin):
    bsz, seq, _ = h.shape
    c_q = rms_norm(h @ w_q_a, q_a_norm)
    q = (c_q @ w_q_b).reshape(bsz, seq, N_HEADS, QK_DIM)
    q_nope = rms_norm(q[..., :QK_NOPE_DIM], q_nope_norm)
    q_rope = apply_rope(rms_norm(q[..., QK_NOPE_DIM:], q_rope_norm),
                        cos[:, :, None, :], sin[:, :, None, :])
    return jnp.concatenate([q_nope, q_rope], axis=-1).transpose(0, 2, 1, 3)


def causal_block_attention(q, k, v):
    bsz, n_heads, seq, dk = q.shape
    dv = v.shape[-1]
    n_blocks = seq // Q_BLOCK
    q_blocks = q.reshape(bsz, n_heads, n_blocks, Q_BLOCK, dk).transpose(2, 0, 1, 3, 4)
    scale = 1.0 / math.sqrt(dk)
    key_pos = jnp.arange(seq)

    def one_block(args):
        q_blk, blk_idx = args
        s = jnp.einsum('bhqd,bhkd->bhqk', q_blk, k).astype(jnp.float32) * scale
        query_pos = blk_idx * Q_BLOCK + jnp.arange(Q_BLOCK)
        s = jnp.where(key_pos[None, :] <= query_pos[:, None], s, NEG_INF)
        p = jax.nn.softmax(s, axis=-1).astype(v.dtype)
        return jnp.einsum('bhqk,bhkd->bhqd', p, v)

    o = lax.map(one_block, (q_blocks, jnp.arange(n_blocks)))
    return o.transpose(1, 2, 0, 3, 4).reshape(bsz, n_heads, seq, dv)


def setup_inputs(seed: int = 0) -> dict:
    key = jax.random.key(seed)
    ks = jax.random.split(key, 32)
    f32 = jnp.float32

    def dense(k, shape, fan_in):
        return jax.random.normal(k, shape, f32) * fan_in ** -0.5

    def gain(k, shape):
        return 1.0 + 0.02 * jax.random.normal(k, shape, f32)

    na, nb = N_A_LAYERS, N_B_LAYERS
    g, n, kk = SSM_GROUPS, SSM_STATE, SSM_GROUP
    x = jax.random.normal(ks[0], (BATCH, SEQ, D_MODEL), f32)
    positions = (jnp.arange(SEQ, dtype=jnp.int32)[None, :]
                 + jax.random.randint(ks[1], (BATCH, 1), 0, SEQ, dtype=jnp.int32))
    mix_norm = gain(ks[2], (DEPTH, D_MODEL))
    ffn_norm = gain(ks[3], (DEPTH, D_MODEL))
    ffn_w_gate_up = dense(ks[4], (DEPTH, D_MODEL, 2 * D_FF), D_MODEL)
    ffn_w_down = dense(ks[5], (DEPTH, D_FF, D_MODEL), D_FF)
    ssm_w_in = dense(ks[6], (na, D_MODEL, D_MODEL), D_MODEL)
    ssm_lambda_re = -0.5 + 0.01 * jax.random.normal(ks[7], (na, g, n), f32)
    ssm_lambda_im = (jnp.pi * jnp.arange(n, dtype=f32)
                     + 0.01 * jax.random.normal(ks[8], (na, g, n), f32))
    ssm_log_step = jax.random.uniform(ks[9], (na, g), f32,
                                      minval=math.log(STEP_MIN), maxval=math.log(STEP_MAX))
    ssm_b_re = dense(ks[10], (na, g, n, kk), 2 * kk)
    ssm_b_im = dense(ks[11], (na, g, n, kk), 2 * kk)
    ssm_c_re = dense(ks[12], (na, g, kk, n), 2 * n)
    ssm_c_im = dense(ks[13], (na, g, kk, n), 2 * n)
    ssm_d = jax.random.normal(ks[14], (na, D_MODEL), f32)
    ssm_w_glu = dense(ks[15], (na, D_MODEL, 2 * D_MODEL), D_MODEL)
    kv_in_norm = gain(ks[16], (D_MODEL,))
    mla_w_kv_a = dense(ks[17], (D_MODEL, KV_LORA_RANK + QK_ROPE_DIM), D_MODEL)
    mla_kv_a_norm = gain(ks[18], (KV_LORA_RANK,))
    mla_w_kv_b = dense(ks[19], (KV_LORA_RANK, N_HEADS * (QK_NOPE_DIM + V_DIM)), KV_LORA_RANK)
    mla_k_nope_norm = gain(ks[20], (QK_NOPE_DIM,))
    mla_k_rope_norm = gain(ks[21], (QK_ROPE_DIM,))
    mla_w_q_a = dense(ks[22], (nb, D_MODEL, Q_LORA_RANK), D_MODEL)
    mla_q_a_norm = gain(ks[23], (nb, Q_LORA_RANK))
    mla_w_q_b = dense(ks[24], (nb, Q_LORA_RANK, N_HEADS * QK_DIM), Q_LORA_RANK)
    mla_q_nope_norm = gain(ks[25], (nb, QK_NOPE_DIM))
    mla_q_rope_norm = gain(ks[26], (nb, QK_ROPE_DIM))
    mla_w_o = dense(ks[27], (nb, N_HEADS * V_DIM, D_MODEL), N_HEADS * V_DIM)
    return {
        'x': x, 'positions': positions,
        'mix_norm': mix_norm, 'ffn_norm': ffn_norm,
        'ffn_w_gate_up': ffn_w_gate_up, 'ffn_w_down': ffn_w_down,
        'ssm_w_in': ssm_w_in, 'ssm_lambda_re': ssm_lambda_re, 'ssm_lambda_im': ssm_lambda_im,
        'ssm_log_step': ssm_log_step, 'ssm_b_re': ssm_b_re, 'ssm_b_im': ssm_b_im,
        'ssm_c_re': ssm_c_re, 'ssm_c_im': ssm_c_im, 'ssm_d': ssm_d, 'ssm_w_glu': ssm_w_glu,
        'kv_in_norm': kv_in_norm, 'mla_w_kv_a': mla_w_kv_a, 'mla_kv_a_norm': mla_kv_a_norm,
        'mla_w_kv_b': mla_w_kv_b, 'mla_k_nope_norm': mla_k_nope_norm,
        'mla_k_rope_norm': mla_k_rope_norm,
        'mla_w_q_a': mla_w_q_a, 'mla_q_a_norm': mla_q_a_norm, 'mla_w_q_b': mla_w_q_b,
        'mla_q_nope_norm': mla_q_nope_norm, 'mla_q_rope_norm': mla_q_rope_norm,
        'mla_w_o': mla_w_o,
    }


def reference(x, positions, mix_norm, ffn_norm, ffn_w_gate_up, ffn_w_down,
              ssm_w_in, ssm_lambda_re, ssm_lambda_im, ssm_log_step, ssm_b_re, ssm_b_im,
              ssm_c_re, ssm_c_im, ssm_d, ssm_w_glu,
              kv_in_norm, mla_w_kv_a, mla_kv_a_norm, mla_w_kv_b, mla_k_nope_norm,
              mla_k_rope_norm, mla_w_q_a, mla_q_a_norm, mla_w_q_b, mla_q_nope_norm,
              mla_q_rope_norm, mla_w_o):
    bsz, seq, _ = x.shape
    cos, sin = rope_tables(positions)
    k_shared, v_shared = None, None
    for layer in range(DEPTH):
        h = rms_norm(x, mix_norm[layer])
        if layer < N_A_LAYERS:
            i = layer
            x = x + s5_mixer(h, ssm_w_in[i], ssm_lambda_re[i], ssm_lambda_im[i], ssm_log_step[i],
                             ssm_b_re[i], ssm_b_im[i], ssm_c_re[i], ssm_c_im[i], ssm_d[i],
                             ssm_w_glu[i])
        else:
            j = layer - N_A_LAYERS
            if j == 0:
                k_shared, v_shared = mla_shared_kv(rms_norm(x, kv_in_norm), mla_w_kv_a,
                                                   mla_kv_a_norm, mla_w_kv_b, mla_k_nope_norm,
                                                   mla_k_rope_norm, cos, sin)
            q = mla_queries(h, mla_w_q_a[j], mla_q_a_norm[j], mla_w_q_b[j],
                            mla_q_nope_norm[j], mla_q_rope_norm[j], cos, sin)
            o = causal_block_attention(q, k_shared, v_shared)
            o = o.transpose(0, 2, 1, 3).reshape(bsz, seq, N_HEADS * V_DIM)
            x = x + o @ mla_w_o[j]
        x = x + swiglu_ffn(rms_norm(x, ffn_norm[layer]), ffn_w_gate_up[layer], ffn_w_down[layer])
    return x
```

```cpp
#include <hip/hip_runtime.h>
#include <hip/hip_cooperative_groups.h>
#include <cstdio>
#include <cstdint>
namespace cg = cooperative_groups;

#define LAS __attribute__((address_space(3)))
typedef unsigned short bf16_t;
typedef short bf16x8 __attribute__((ext_vector_type(8)));
typedef float f32x4 __attribute__((ext_vector_type(4)));
typedef float f32x16 __attribute__((ext_vector_type(16)));
typedef unsigned u32x4 __attribute__((ext_vector_type(4)));
typedef unsigned u32x2 __attribute__((ext_vector_type(2)));
typedef float f32x2_t __attribute__((ext_vector_type(2)));
typedef __bf16 bf16x2_t __attribute__((ext_vector_type(2)));

constexpr int T = 65536, DM = 1024, SEQ = 2048, NB = 32, FF = 2816, NH = 16;
constexpr float EPS = 1e-6f;
constexpr float QSCALE = 0.14724444f;

constexpr size_t MiB = 1u << 20;
constexpr size_t WS_WIN = 0, WS_WGLU = 4 * MiB, WS_WGU = 12 * MiB, WS_WDN = 56 * MiB, WS_WQKVA = 78 * MiB, WS_WQA3 = 80 * MiB,
                 WS_WQB = 81 * MiB, WS_WKVB = 84 * MiB, WS_WO = 85 * MiB, WS_BTY = 90 * MiB, WS_BTP = 114 * MiB, WS_AC = 130 * MiB,
                 WS_ROPE = 131 * MiB, WS_SLOT = 139 * MiB, WS_SLOT2 = 147 * MiB, WS_XB = 155 * MiB,
                 WS_KF = 283 * MiB, WS_VT = 475 * MiB, WS_R = 603 * MiB, WS_END = 1024 * MiB;
constexpr size_t WS_BAR = 130 * MiB + 512 * 1024, WS_BAR_BYTES = 16384;
constexpr size_t WS_AG = 283 * MiB, WS_WST = 475 * MiB, WS_Z = 603 * MiB;
constexpr size_t WS_FFA = WS_R, WS_KVRAW = WS_R, WS_QRAW = WS_R, WS_O = WS_R + 196 * MiB, WS_QKVA = WS_R + 300 * MiB;

enum { I_X = 0, I_POS, I_MIXN, I_FFNN, I_WGU, I_WDN, I_SWIN, I_LRE, I_LIM, I_LSTEP, I_BRE, I_BIM, I_CRE, I_CIM, I_SD, I_SGLU,
       I_KVINN, I_WKVA, I_KVAN, I_WKVB, I_KNOPEN, I_KROPEN, I_WQA, I_QAN, I_WQB, I_QNOPEN, I_QROPEN, I_WO, N_IN };

__device__ __forceinline__ int opq_v(int v) { asm volatile("" : "+v"(v)); return v; }
__device__ __forceinline__ int opq_s(int v) { asm volatile("" : "+s"(v)); return v; }
__device__ __forceinline__ int lane_id_opq() { unsigned z = 0u; asm volatile("" : "+v"(z)); return (int)__builtin_amdgcn_mbcnt_hi(~0u, __builtin_amdgcn_mbcnt_lo(~0u, z)); }
__device__ __forceinline__ unsigned cvtpk(float lo, float hi) { f32x2_t v = {lo, hi}; bf16x2_t b = __builtin_convertvector(v, bf16x2_t); return __builtin_bit_cast(unsigned, b); }
__device__ __forceinline__ float bflo(unsigned w) { return __uint_as_float(w << 16); }
__device__ __forceinline__ float bfhi(unsigned w) { return __uint_as_float(w & 0xffff0000u); }
__device__ __forceinline__ float sigmoidf_(float x) { return __builtin_amdgcn_rcpf(1.0f + __builtin_amdgcn_exp2f(-1.4426950408889634f * x)); }
__device__ __forceinline__ float gelu_tanh(float x) { const float u = 1.5957691216057308f * (x + 0.044715f * x * x * x); return x * sigmoidf_(u); }

namespace pg8 {
constexpr int BM = 256, BK = 64, HALF = 128, HTB = HALF * BK * 2, STAGE_BYTES = 8 * HTB, NXCD = 8, WGM = 8;
__host__ __device__ __forceinline__ int lds_byte(int r, int c) { const int st = (r >> 4) * 2 + (c >> 5), rr = r & 15, cc = c & 31, ob = rr * 64 + cc * 2; return st * 1024 + (ob ^ (((ob >> 9) & 1) << 5)); }
__host__ __device__ __forceinline__ void stage_rc(int b, int& R, int& C) { const int st = b / 1024, sb = b % 1024, swz = sb ^ (((sb >> 9) & 1) << 5); R = (st >> 1) * 16 + swz / 64; C = (st & 1) * 32 + (swz % 64) / 2; }
__host__ __device__ __forceinline__ int perm32(int rho) { const int n = rho >> 4, i = rho & 15; return 8 * (i >> 2) + 4 * n + (i & 3); }

struct Unit { int pm, pn, pg; };
struct Gemm { const bf16_t* A; const bf16_t* Bt; int K, lda, ldb; long gsA, gsB; };

struct Sched {
    int nM, nN, nwg, nG, G, c;
    __device__ void init(int M, int N, int nG_, int G_, int c_) { nM = M / BM; nN = N / BM; nwg = nM * nN; nG = nG_; G = G_; c = c_; }
    __device__ bool next(int i, Unit& u) const {
        const long L = (long)i * G + c; if (L >= (long)nwg * nG) return false;
        u.pg = (int)(L / nwg); int wgid = (int)(L % nwg);
        { const int q = nwg / NXCD, r = nwg % NXCD, xcd = wgid % NXCD, off = wgid / NXCD; wgid = (xcd < r ? xcd * (q + 1) : r * (q + 1) + (xcd - r) * q) + off; }
        const int nig = WGM * nN, gid = wgid / nig, fm = gid * WGM, gsz = (nM - fm) < WGM ? (nM - fm) : WGM;
        u.pm = fm + ((wgid % nig) % gsz); u.pn = (wgid % nig) / gsz; return true;
    }
};

template <class Epi, bool ALIGN_EPI>
__device__ __forceinline__ void gemm_phase(LAS unsigned char* lds, const Gemm g, const Sched& S, const Epi& E, int tid_in) {
    int tid_ = tid_in; asm volatile("" : "+v"(tid_));
    const int tid = tid_, wid = __builtin_amdgcn_readfirstlane(tid >> 6), lane = tid & 63, wr = wid >> 2, wc = wid & 3, fr = lane & 15, fq = lane >> 4;
    const int K = g.K, nt = K / BK;
    unsigned voffA[2], voffB[2];
#pragma unroll
    for (int i = 0; i < 2; ++i) { int R, C; stage_rc(tid * 16 + i * 8192, R, C); const int Rb = (R & ~31) + perm32(R & 31);
        voffA[i] = (unsigned)(R * g.lda + C) * 2u; voffB[i] = (unsigned)(Rb * g.ldb + C) * 2u; }
    const size_t kstep = (size_t)(BK * 2);
    const size_t hsA = (size_t)HALF * g.lda * 2, hsB = (size_t)HALF * g.ldb * 2;
    const size_t tsA = 2 * hsA, tsB = 2 * hsB;
    const unsigned ldsw = (unsigned)wid * 1024u;
    const int aoff = lds_byte(wr * 64 + fr, fq * 8), boff = lds_byte(wc * 32 + fr, fq * 8);
#define PG8_SA(b, h) (((b) * 2 + (h)) * HTB)
#define PG8_SB(b, h) ((4 + (b) * 2 + (h)) * HTB)
#define PG8_STAGE(bufoff, gbase, voff) do { _Pragma("unroll") for (int _i = 0; _i < 2; ++_i) \
        __builtin_amdgcn_global_load_lds((const unsigned*)((const char*)(gbase) + (voff)[_i]), (LAS unsigned*)(lds + (bufoff) + ldsw + _i * 8192), 16, 0, 0); } while (0)
#define PG8_LDA(dst, b, h) do { _Pragma("unroll") for (int m = 0; m < 4; ++m) _Pragma("unroll") for (int k = 0; k < 2; ++k) dst[m][k] = *(const LAS bf16x8*)(lds + PG8_SA(b, h) + aoff + m * 2048 + k * 1024); } while (0)
#define PG8_LDB(dst, b, h) do { _Pragma("unroll") for (int n = 0; n < 2; ++n) _Pragma("unroll") for (int k = 0; k < 2; ++k) dst[n][k] = *(const LAS bf16x8*)(lds + PG8_SB(b, h) + boff + n * 2048 + k * 1024); } while (0)
#define PG8_MMA(ai, bj, At, Bt) do { __builtin_amdgcn_s_setprio(1); _Pragma("unroll") for (int m = 0; m < 4; ++m) _Pragma("unroll") for (int n = 0; n < 2; ++n) _Pragma("unroll") for (int k = 0; k < 2; ++k) \
        acc[ai][bj][m][n] = __builtin_amdgcn_mfma_f32_16x16x32_bf16(Bt[n][k], At[m][k], acc[ai][bj][m][n], 0, 0, 0); __builtin_amdgcn_s_setprio(0); } while (0)
#define PG8_WAIT_V(n) asm volatile("s_waitcnt vmcnt(" #n ")" ::: "memory")
#define PG8_WAIT_L(n) asm volatile("s_waitcnt lgkmcnt(" #n ")" ::: "memory")
#define PG8_BAR __builtin_amdgcn_s_barrier()
#define PG8_SCHED __builtin_amdgcn_sched_barrier(0)
    Unit cur, nxt; int ui = 0;
    if (!S.next(0, cur)) return;
    f32x4 acc[2][2][4][2];
#pragma unroll
    for (int a = 0; a < 2; ++a)
#pragma unroll
        for (int b = 0; b < 2; ++b)
#pragma unroll
            for (int m = 0; m < 4; ++m)
#pragma unroll
                for (int n = 0; n < 2; ++n) acc[a][b][m][n] = (f32x4){0.f, 0.f, 0.f, 0.f};
    bf16x8 At[4][2], B0[2][2], B1[2][2];
    const char* cA = (const char*)(g.A + (size_t)cur.pg * g.gsA) + (size_t)cur.pm * tsA;
    const char* cB = (const char*)(g.Bt + (size_t)cur.pg * g.gsB) + (size_t)cur.pn * tsB;
    PG8_STAGE(PG8_SB(0, 0), cB, voffB); PG8_STAGE(PG8_SB(0, 1), cB + hsB, voffB); PG8_STAGE(PG8_SA(0, 0), cA, voffA); PG8_STAGE(PG8_SA(0, 1), cA + hsA, voffA);
    if (wr == 1) PG8_BAR;
    PG8_WAIT_V(2); PG8_BAR;
    PG8_STAGE(PG8_SB(1, 0), cB + kstep, voffB); PG8_STAGE(PG8_SA(1, 0), cA + kstep, voffA); PG8_STAGE(PG8_SB(1, 1), cB + hsB + kstep, voffB);
    PG8_WAIT_V(6); PG8_BAR;
    for (;;) {
        const bool has_next = S.next(ui + 1, nxt);
        const char* nA = has_next ? (const char*)(g.A + (size_t)nxt.pg * g.gsA) + (size_t)nxt.pm * tsA : cA;
        const char* nB = has_next ? (const char*)(g.Bt + (size_t)nxt.pg * g.gsB) + (size_t)nxt.pn * tsB : cB;
        for (int t = 0; t < nt; t += 2) {
            const bool last = (t == nt - 2);
            const char* a1 = cA + (size_t)(t + 1) * kstep;
            const char* a2 = last ? nA : cA + (size_t)(t + 2) * kstep; const char* b2 = last ? nB : cB + (size_t)(t + 2) * kstep;
            const char* a3 = a2 + kstep; const char* b3 = b2 + kstep;
            PG8_LDB(B0, 0, 0); PG8_LDB(B1, 0, 1); PG8_SCHED; PG8_LDA(At, 0, 0); PG8_STAGE(PG8_SA(1, 1), a1 + hsA, voffA);
            PG8_WAIT_V(8); PG8_WAIT_L(0); PG8_BAR; PG8_MMA(0, 0, At, B0); PG8_MMA(0, 1, At, B1); PG8_BAR; PG8_SCHED;
            PG8_LDA(At, 0, 1); PG8_STAGE(PG8_SB(0, 0), b2, voffB); PG8_STAGE(PG8_SB(0, 1), b2 + hsB, voffB); PG8_STAGE(PG8_SA(0, 0), a2, voffA);
            PG8_WAIT_V(8); PG8_WAIT_L(0); PG8_BAR; PG8_MMA(1, 0, At, B0); PG8_MMA(1, 1, At, B1); PG8_BAR; PG8_SCHED;
            PG8_LDB(B0, 1, 0); PG8_LDB(B1, 1, 1); PG8_SCHED; PG8_LDA(At, 1, 0); PG8_STAGE(PG8_SA(0, 1), a2 + hsA, voffA);
            PG8_WAIT_V(8); PG8_WAIT_L(0); PG8_BAR; PG8_MMA(0, 0, At, B0); PG8_MMA(0, 1, At, B1); PG8_BAR; PG8_SCHED;
            PG8_LDA(At, 1, 1); PG8_STAGE(PG8_SB(1, 0), b3, voffB); PG8_STAGE(PG8_SB(1, 1), b3 + hsB, voffB); PG8_STAGE(PG8_SA(1, 0), a3, voffA);
            PG8_WAIT_V(8); PG8_WAIT_L(0); PG8_BAR; PG8_MMA(1, 0, At, B0); PG8_MMA(1, 1, At, B1); PG8_BAR; PG8_SCHED;
        }
        if constexpr (ALIGN_EPI) { if (wr == 0) PG8_BAR; }
        E(acc, cur, wr, wc, fr, fq);
        if (!has_next) break;
#pragma unroll
        for (int a = 0; a < 2; ++a)
#pragma unroll
            for (int b = 0; b < 2; ++b)
#pragma unroll
                for (int m = 0; m < 4; ++m)
#pragma unroll
                    for (int n = 0; n < 2; ++n) acc[a][b][m][n] = (f32x4){0.f, 0.f, 0.f, 0.f};
        cur = nxt; cA = nA; cB = nB; ++ui;
        if constexpr (ALIGN_EPI) { if (wr == 1) PG8_BAR; }
    }
    PG8_WAIT_V(0);
    if constexpr (!ALIGN_EPI) { if (wr == 0) PG8_BAR; }
    PG8_BAR;
#undef PG8_SA
#undef PG8_SB
#undef PG8_STAGE
#undef PG8_LDA
#undef PG8_LDB
#undef PG8_MMA
#undef PG8_WAIT_V
#undef PG8_WAIT_L
#undef PG8_BAR
#undef PG8_SCHED
}

struct RowScale {
    const float* slots; int s0, npf; float inv_n;
    __device__ __forceinline__ float get(int row, int fq) const {
        const float* p = slots + (size_t)row * 32 + s0 + fq * npf; float s = 0.f;
        for (int i = 0; i < npf; ++i) s += p[i];
        s += __shfl_xor(s, 16); s += __shfl_xor(s, 32);
        return rsqrtf(s * inv_n + EPS);
    }
};
__device__ __forceinline__ float ssq8(const f32x4& a, const f32x4& b) { return (a[0] * a[0] + a[1] * a[1]) + (a[2] * a[2] + a[3] * a[3]) + (b[0] * b[0] + b[1] * b[1]) + (b[2] * b[2] + b[3] * b[3]); }
__device__ __forceinline__ u32x4 pack8(const f32x4& a, const f32x4& b) { u32x4 w; w.x = cvtpk(a[0], a[1]); w.y = cvtpk(a[2], a[3]); w.z = cvtpk(b[0], b[1]); w.w = cvtpk(b[2], b[3]); return w; }

template <int MODE, bool SSQ> struct EpiScaleBf16 {
    bf16_t* O; int ldc; RowScale rs; float* ssq;
    __device__ __forceinline__ void operator()(const f32x4 (&acc)[2][2][4][2], const Unit& u, int wr, int wc, int fr, int fq) const {
        { const int l_ = lane_id_opq(); fr = l_ & 15; fq = l_ >> 4; }
        const int row0 = u.pm * BM + wr * 64 + fr, colb = u.pn * BM + wc * 32 + 8 * fq;
#pragma unroll
        for (int ai = 0; ai < 2; ++ai)
#pragma unroll
            for (int m = 0; m < 4; ++m) { const int row = row0 + ai * HALF + m * 16; const float r = rs.get(row, fq);
#pragma unroll
                for (int bj = 0; bj < 2; ++bj) { const int col = colb + bj * HALF; const f32x4 v0 = acc[ai][bj][m][0] * r, v1 = acc[ai][bj][m][1] * r;
                    bf16_t* p = (MODE == 0) ? O + (size_t)row * ldc + col : O + ((size_t)(col >> 4) * 4096 + (row >> 4)) * 384 + (row & 15) * 16 + (col & 15);
                    *(u32x4*)p = pack8(v0, v1);
                    if (SSQ) { float s = ssq8(v0, v1); s += __shfl_xor(s, 16); s += __shfl_xor(s, 32); if (fq == 0) ssq[(size_t)row * 32 + (u.pn * 2 + bj) * 4 + wc] = s; } }
                asm volatile("" ::: "memory"); }
    }
};
template <bool GLU> struct EpiRes {
    float* xout; bf16_t* xb; float* ssq; bool wf32;
    __device__ __forceinline__ void operator()(const f32x4 (&acc)[2][2][4][2], const Unit& u, int wr, int wc, int fr, int fq) const {
        { const int l_ = lane_id_opq(); fr = l_ & 15; fq = l_ >> 4; }
        const int row0 = u.pm * BM + wr * 64 + fr;
#pragma unroll
        for (int ai = 0; ai < 2; ++ai)
#pragma unroll
            for (int m = 0; m < 4; ++m) { const int row = row0 + ai * HALF + m * 16;
#pragma unroll
                for (int bj = 0; bj < (GLU ? 1 : 2); ++bj) { f32x4 v0, v1; int col, slot;
                    if (GLU) { col = u.pn * HALF + wc * 32 + 8 * fq; slot = u.pn * 4 + wc;
#pragma unroll
                        for (int e = 0; e < 4; ++e) { v0[e] = acc[ai][0][m][0][e] * sigmoidf_(acc[ai][1][m][0][e]); v1[e] = acc[ai][0][m][1][e] * sigmoidf_(acc[ai][1][m][1][e]); }
                    } else { col = u.pn * BM + bj * HALF + wc * 32 + 8 * fq; slot = (u.pn * 2 + bj) * 4 + wc; v0 = acc[ai][bj][m][0]; v1 = acc[ai][bj][m][1]; }
                    const size_t p = (size_t)row * DM + col; const u32x4 xw = *(const u32x4*)(xb + p);
                    const f32x4 x0 = (f32x4){bflo(xw.x), bfhi(xw.x), bflo(xw.y), bfhi(xw.y)} + v0, x1 = (f32x4){bflo(xw.z), bfhi(xw.z), bflo(xw.w), bfhi(xw.w)} + v1;
                    if (wf32) { *(f32x4*)(xout + p) = x0; *(f32x4*)(xout + p + 4) = x1; }
                    *(u32x4*)(xb + p) = pack8(x0, x1);
                    float s = ssq8(x0, x1); s += __shfl_xor(s, 16); s += __shfl_xor(s, 32); if (fq == 0) ssq[(size_t)row * 32 + slot] = s; }
                asm volatile("" ::: "memory"); }
    }
};
struct EpiSwiGLU {
    bf16_t* O; RowScale rs;
    __device__ __forceinline__ void operator()(const f32x4 (&acc)[2][2][4][2], const Unit& u, int wr, int wc, int fr, int fq) const {
        { const int l_ = lane_id_opq(); fr = l_ & 15; fq = l_ >> 4; }
        const int row0 = u.pm * BM + wr * 64 + fr, col = u.pn * HALF + wc * 32 + 8 * fq;
#pragma unroll
        for (int ai = 0; ai < 2; ++ai)
#pragma unroll
            for (int m = 0; m < 4; ++m) { const int row = row0 + ai * HALF + m * 16; const float r = rs.get(row, fq); f32x4 v0, v1;
#pragma unroll
                for (int e = 0; e < 4; ++e) { const float g0 = acc[ai][0][m][0][e] * r, g1 = acc[ai][0][m][1][e] * r;
                    v0[e] = g0 * sigmoidf_(g0) * (acc[ai][1][m][0][e] * r); v1[e] = g1 * sigmoidf_(g1) * (acc[ai][1][m][1][e] * r); }
                *(u32x4*)(O + (size_t)row * FF + col) = pack8(v0, v1); asm volatile("" ::: "memory"); }
    }
};
struct EpiSsmP {
    float* W;
    __device__ __forceinline__ void operator()(const f32x4 (&acc)[2][2][4][2], const Unit& u, int wr, int wc, int fr, int fq) const {
        { const int l_ = lane_id_opq(); fr = l_ & 15; fq = l_ >> 4; }
        const int row0 = u.pm * BM + wr * 64 + fr;
#pragma unroll
        for (int ai = 0; ai < 2; ++ai)
#pragma unroll
            for (int m = 0; m < 4; ++m) { const int row = row0 + ai * HALF + m * 16; float* p = W + ((size_t)u.pg * 4096 + row) * 128 + wc * 32 + 8 * fq;
                *(f32x4*)p = acc[ai][0][m][0]; *(f32x4*)(p + 4) = acc[ai][0][m][1]; }
    }
};
struct EpiSsmY {
    const bf16_t* Ag; const float* dskip; bf16_t* z;
    __device__ __forceinline__ void operator()(const f32x4 (&acc)[2][2][4][2], const Unit& u, int wr, int wc, int fr, int fq) const {
        { const int l_ = lane_id_opq(); fr = l_ & 15; fq = l_ >> 4; }
        const int row0 = u.pm * BM + wr * 64 + fr, k0 = (fq & 1) * 8;
#pragma unroll
        for (int ai = 0; ai < 2; ++ai)
#pragma unroll
            for (int m = 0; m < 4; ++m) { const int row = row0 + ai * HALF + m * 16;
#pragma unroll
                for (int bj = 0; bj < 2; ++bj) { const int col = bj * HALF + wc * 32 + 8 * fq, t = col >> 4;
                    const u32x4 uw = *(const u32x4*)(Ag + ((size_t)u.pg * 4096 + row) * 384 + col);
                    const f32x4 d0 = *(const f32x4*)(dskip + u.pg * 16 + k0), d1 = *(const f32x4*)(dskip + u.pg * 16 + k0 + 4);
                    f32x4 y0 = acc[ai][bj][m][0], y1 = acc[ai][bj][m][1];
                    y0[0] += d0[0] * bflo(uw.x); y0[1] += d0[1] * bfhi(uw.x); y0[2] += d0[2] * bflo(uw.y); y0[3] += d0[3] * bfhi(uw.y);
                    y1[0] += d1[0] * bflo(uw.z); y1[1] += d1[1] * bfhi(uw.z); y1[2] += d1[2] * bflo(uw.w); y1[3] += d1[3] * bfhi(uw.w);
#pragma unroll
                    for (int e = 0; e < 4; ++e) { y0[e] = gelu_tanh(y0[e]); y1[e] = gelu_tanh(y1[e]); }
                    *(u32x4*)(z + ((size_t)row * 16 + t) * DM + u.pg * 16 + k0) = pack8(y0, y1); asm volatile("" ::: "memory"); } }
    }
};
struct EpiHead {
    bf16_t* O; RowScale rs; const float* gn; const float* gr; const float* rc; const float* rsn; float osc;
    __device__ __forceinline__ void operator()(const f32x4 (&acc)[2][2][4][2], const Unit& u, int wr, int wc, int fr, int fq) const {
        { const int l_ = lane_id_opq(); fr = l_ & 15; fq = l_ >> 4; }
        const int row0 = u.pm * BM + wr * 64 + fr;
        if (u.pn < 4) { const int h = 4 * u.pn + wc;
#pragma unroll
            for (int ai = 0; ai < 2; ++ai)
#pragma unroll
                for (int m = 0; m < 4; ++m) { const int row = row0 + ai * HALF + m * 16; const float r = rs.get(row, fq);
                    const f32x4 a0 = acc[ai][0][m][0] * r, a1 = acc[ai][0][m][1] * r, b0 = acc[ai][1][m][0] * r, b1 = acc[ai][1][m][1] * r;
                    float s = ssq8(a0, a1) + ssq8(b0, b1); s += __shfl_xor(s, 16); s += __shfl_xor(s, 32);
                    const float rh = rsqrtf(s * (1.0f / 64) + EPS) * osc;
                    bf16_t* p = O + (size_t)row * 1536 + h * 96 + 8 * fq;
                    { const f32x4 g0 = *(const f32x4*)(gn + 8 * fq), g1 = *(const f32x4*)(gn + 8 * fq + 4); *(u32x4*)p = pack8(a0 * g0 * rh, a1 * g1 * rh); }
                    { const f32x4 g0 = *(const f32x4*)(gn + 32 + 8 * fq), g1 = *(const f32x4*)(gn + 32 + 8 * fq + 4); *(u32x4*)(p + 32) = pack8(b0 * g0 * rh, b1 * g1 * rh); }
                    asm volatile("" ::: "memory"); }
        } else { const int h = 8 * (u.pn - 4) + 2 * wc + (fq >> 1), i0 = (fq & 1) * 8;
#pragma unroll
            for (int ai = 0; ai < 2; ++ai)
#pragma unroll
                for (int m = 0; m < 4; ++m) { const int row = row0 + ai * HALF + m * 16; const float r = rs.get(row, fq);
                    f32x4 x1a = acc[ai][0][m][0] * r, x1b = acc[ai][0][m][1] * r, x2a = acc[ai][1][m][0] * r, x2b = acc[ai][1][m][1] * r;
                    float s = ssq8(x1a, x1b) + ssq8(x2a, x2b); s += __shfl_xor(s, 16);
                    const float rh = rsqrtf(s * (1.0f / 32) + EPS);
                    x1a = x1a * *(const f32x4*)(gr + i0) * rh; x1b = x1b * *(const f32x4*)(gr + i0 + 4) * rh; x2a = x2a * *(const f32x4*)(gr + 16 + i0) * rh; x2b = x2b * *(const f32x4*)(gr + 16 + i0 + 4) * rh;
                    const f32x4 ca = *(const f32x4*)(rc + (size_t)row * 16 + i0) * osc, cb = *(const f32x4*)(rc + (size_t)row * 16 + i0 + 4) * osc, sa = *(const f32x4*)(rsn + (size_t)row * 16 + i0) * osc, sb = *(const f32x4*)(rsn + (size_t)row * 16 + i0 + 4) * osc;
                    bf16_t* p = O + (size_t)row * 1536 + h * 96 + 64 + i0;
                    *(u32x4*)p = pack8(x1a * ca - x2a * sa, x1b * cb - x2b * sb);
                    *(u32x4*)(p + 16) = pack8(x1a * sa + x2a * ca, x1b * sb + x2b * cb);
                    asm volatile("" ::: "memory"); }
        }
    }
};
struct EpiVt {
    bf16_t* Vt; const float* slots2;
    __device__ __forceinline__ void operator()(const f32x4 (&acc)[2][2][4][2], const Unit& u, int wr, int wc, int fr, int fq) const {
        { const int l_ = lane_id_opq(); fr = l_ & 15; fq = l_ >> 4; }
        const int row0 = u.pm * BM + wr * 64 + fr;
#pragma unroll
        for (int bj = 0; bj < 2; ++bj) { const int tok0 = u.pn * BM + bj * HALF + wc * 32 + 8 * fq, b = tok0 >> 11, l = tok0 & 2047;
            float rt[8];
#pragma unroll
            for (int e = 0; e < 8; ++e) { const float* p = slots2 + (size_t)(tok0 + e) * 32 + 12; const f32x4 a = *(const f32x4*)p, b2 = *(const f32x4*)(p + 4);
                rt[e] = rsqrtf(((a[0] + a[1]) + (a[2] + a[3]) + (b2[0] + b2[1]) + (b2[2] + b2[3])) * (1.0f / 256) + EPS);
                if ((e & 1) == 1) asm volatile("" ::: "memory"); }
#pragma unroll
            for (int ai = 0; ai < 2; ++ai)
#pragma unroll
                for (int m = 0; m < 4; ++m) { const int row = row0 + ai * HALF + m * 16;
                    f32x4 v0 = acc[ai][bj][m][0], v1 = acc[ai][bj][m][1];
#pragma unroll
                    for (int e = 0; e < 4; ++e) { v0[e] *= rt[e]; v1[e] *= rt[4 + e]; }
                    *(u32x4*)(Vt + ((size_t)(b * 1024 + row)) * SEQ + l) = pack8(v0, v1); }
            asm volatile("" ::: "memory"); }
    }
};
}

struct Args { const float* in[N_IN]; float* out; unsigned char* ws; int ph_lo, ph_hi; };

__device__ __forceinline__ void sincos_rev(double rev, float& sn, float& cs) {
    const double fr = rev - rint(rev); const double q = rint(4.0 * fr); const double y = fr - 0.25 * q; const double x = 6.283185307179586 * y, x2 = x * x;
    const double s = x * (1.0 + x2 * (-1.0 / 6 + x2 * (1.0 / 120 + x2 * (-1.0 / 5040 + x2 * (1.0 / 362880 + x2 * (-1.0 / 39916800 + x2 * (1.0 / 6227020800.0)))))));
    const double c = 1.0 + x2 * (-0.5 + x2 * (1.0 / 24 + x2 * (-1.0 / 720 + x2 * (1.0 / 40320 + x2 * (-1.0 / 3628800 + x2 * (1.0 / 479001600.0 + x2 * (-1.0 / 87178291200.0)))))));
    const int qi = ((int)q) & 3;
    const double ss = (qi == 0) ? s : (qi == 1) ? c : (qi == 2) ? -s : -c;
    const double cc = (qi == 0) ? c : (qi == 1) ? -s : (qi == 2) ? -c : s;
    sn = (float)ss; cs = (float)cc;
}

__device__ __forceinline__ void tr_item(const float* W, int K, int N, const float* gain, bf16_t* dst, int ldk, int mode, int H, int drow0, LAS float* scr, int item, int lane) {
    const int nblk = N / 32, kb = item / nblk, nb = item % nblk, k0 = 64 * kb, n0 = 32 * nb;
#pragma unroll 8
    for (int i = 0; i < 32; ++i) { const int kk = 2 * i + (lane >> 5); float v = W[(size_t)(k0 + kk) * N + n0 + (lane & 31)]; if (gain) v *= gain[k0 + kk]; scr[kk * 33 + (lane & 31)] = v; }
    asm volatile("s_waitcnt lgkmcnt(0)" ::: "memory");
    int drow, extra16 = 0;
    if (mode == 0) drow = drow0 + n0;
    else if (mode == 1) { const int half = n0 / H, j = n0 % H; drow = drow0 + (j / 128) * 256 + half * 128 + (j % 128); }
    else if (mode == 2) { const int h = n0 / 128, part = (n0 % 128) / 32;
        drow = (part < 2) ? (h / 4) * 256 + part * 128 + (h % 4) * 32 : 1024 + h * 64 + (part - 2) * 32; }
    else { const int h = n0 / 96, part = (n0 % 96) / 32;
        if (part < 2) drow = (h / 4) * 256 + part * 128 + (h % 4) * 32; else { drow = 1024 + (h / 8) * 256 + ((h % 8) / 2) * 32 + (h % 2) * 16; extra16 = 112; } }
    const int c = lane & 7;
#pragma unroll
    for (int j = 0; j < 4; ++j) { const int n = (lane >> 3) + 8 * j; const LAS float* s = scr + (8 * c) * 33 + n;
        u32x4 o; o.x = cvtpk(s[0 * 33], s[1 * 33]); o.y = cvtpk(s[2 * 33], s[3 * 33]); o.z = cvtpk(s[4 * 33], s[5 * 33]); o.w = cvtpk(s[6 * 33], s[7 * 33]);
        *(u32x4*)(dst + (size_t)(drow + n + (n >= 16 ? extra16 : 0)) * ldk + k0 + 8 * c) = o; }
    asm volatile("s_waitcnt lgkmcnt(0)" ::: "memory");
}

__device__ __forceinline__ void ssm_precompute(const Args& a, LAS unsigned char* lds, int job, int tid_in) {
    const int tid = opq_v(tid_in), i = job >> 6, g = job & 63, ig = i * 64 + g;
    LAS float* apr = (LAS float*)lds;
    LAS float* api = apr + 17 * 64;
    LAS float* bbr = api + 17 * 64;
    LAS float* bbi = bbr + 1024;
    LAS float* ccr = bbi + 1024;
    LAS float* cci = ccr + 1024;
    LAS float* kern = cci + 1024;
    const float* lam_re = a.in[I_LRE] + (size_t)ig * 64; const float* lam_im = a.in[I_LIM] + (size_t)ig * 64;
    const double step = exp((double)a.in[I_LSTEP][ig]);
    __syncthreads();
    for (int idx = tid; idx < 17 * 64; idx += 512) { const int d = idx >> 6, n = idx & 63;
        const double lr = (double)lam_re[n], li = (double)lam_im[n];
        const double mag = exp(lr * step * d); float sn, cs; sincos_rev(li * step * d * 0.15915494309189535, sn, cs);
        apr[idx] = (float)(mag * cs); api[idx] = (float)(mag * sn); }
    for (int idx = tid; idx < 1024; idx += 512) { ccr[idx] = a.in[I_CRE][(size_t)ig * 1024 + idx]; cci[idx] = a.in[I_CIM][(size_t)ig * 1024 + idx]; }
    __syncthreads();
    for (int idx = tid; idx < 1024; idx += 512) { const int n = idx >> 4;
        const float lr = lam_re[n], li = lam_im[n], are = apr[64 + n], aim = api[64 + n], den = lr * lr + li * li;
        const float fre = ((are - 1.0f) * lr + aim * li) / den, fim = (aim * lr - (are - 1.0f) * li) / den;
        const float br = a.in[I_BRE][(size_t)ig * 1024 + idx], bi = a.in[I_BIM][(size_t)ig * 1024 + idx];
        bbr[idx] = fre * br - fim * bi; bbi[idx] = fre * bi + fim * br; }
    __syncthreads();
    for (int idx = tid; idx < 4096; idx += 512) { const int d = idx >> 8, k = (idx >> 4) & 15, kp = idx & 15; float s = 0.f;
        for (int n = 0; n < 64; ++n) { const float pr = apr[d * 64 + n], pi = api[d * 64 + n], br = bbr[n * 16 + kp], bi = bbi[n * 16 + kp];
            const float tr = pr * br - pi * bi, ti = pr * bi + pi * br; s += ccr[k * 64 + n] * tr - cci[k * 64 + n] * ti; }
        kern[idx] = s; }
    __syncthreads();
    bf16_t* bty = (bf16_t*)(a.ws + WS_BTY) + (size_t)ig * 256 * 384;
    for (int idx = tid; idx < 256 * 384; idx += 512) { const int row = idx / 384, col = idx % 384, t = row >> 4, k = row & 15; float v;
        if (col < 256) { const int j = col >> 4, kp = col & 15; v = (j <= t) ? kern[(t - j) * 256 + k * 16 + kp] : 0.f; }
        else if (col < 320) { const int n = col - 256; v = ccr[k * 64 + n] * apr[(t + 1) * 64 + n] - cci[k * 64 + n] * api[(t + 1) * 64 + n]; }
        else { const int n = col - 320; v = -(ccr[k * 64 + n] * api[(t + 1) * 64 + n] + cci[k * 64 + n] * apr[(t + 1) * 64 + n]); }
        bty[idx] = (bf16_t)(cvtpk(v, 0.f) & 0xffffu); }
    bf16_t* btp = (bf16_t*)(a.ws + WS_BTP) + (size_t)ig * 256 * 256;
    for (int idx = tid; idx < 256 * 256; idx += 512) { const int row = idx >> 8, col = idx & 255, j = col >> 4, kp = col & 15; float v = 0.f;
        if (row < 128) { const int n = row & 63; const float pr = apr[(15 - j) * 64 + n], pi = api[(15 - j) * 64 + n], br = bbr[n * 16 + kp], bi = bbi[n * 16 + kp];
            v = (row < 64) ? (pr * br - pi * bi) : (pr * bi + pi * br); }
        btp[idx] = (bf16_t)(cvtpk(v, 0.f) & 0xffffu); }
    float* ac = (float*)(a.ws + WS_AC) + (size_t)ig * 128;
    if (tid < 64) { ac[tid] = apr[16 * 64 + tid]; ac[64 + tid] = api[16 * 64 + tid]; }
    __syncthreads();
}

__device__ __forceinline__ void phase_setup(const Args& a, LAS unsigned char* lds, int tid_in) {
    const int tid = opq_v(tid_in), lane = tid & 63, wave = tid >> 6, G = opq_s(gridDim.x), bx = opq_s(blockIdx.x);
    for (int job = bx; job < 128; job += G) ssm_precompute(a, lds, job, tid_in);
    __syncthreads();
    LAS float* scr = (LAS float*)(lds + wave * 8448);
    const int gw = bx * 8 + wave, NGW = G * 8;
    unsigned char* ws = a.ws;
    constexpr int I_GU = 16 * 176, I_DN = 44 * 32, I_IN = 16 * 32, I_GL = 16 * 64, I_QA = 16 * 12, I_KVA = 16 * 9, I_QB = 6 * 48, I_KVB = 4 * 64, I_O = 16 * 32;
    constexpr int NITEMS = 4 * I_GU + 4 * I_DN + 2 * I_IN + 2 * I_GL + 2 * I_QA + I_KVA + 2 * I_QB + I_KVB + 2 * I_O;
    for (int it = gw; it < NITEMS; it += NGW) {
        int r = it;
        if (r < 4 * I_GU) { const int l = r / I_GU; tr_item(a.in[I_WGU] + (size_t)l * DM * 2 * FF, DM, 2 * FF, a.in[I_FFNN] + l * DM, (bf16_t*)(ws + WS_WGU) + (size_t)l * 2 * FF * DM, DM, 1, FF, 0, scr, r % I_GU, lane); continue; } r -= 4 * I_GU;
        if (r < 4 * I_DN) { const int l = r / I_DN; tr_item(a.in[I_WDN] + (size_t)l * FF * DM, FF, DM, nullptr, (bf16_t*)(ws + WS_WDN) + (size_t)l * DM * FF, FF, 0, 1, 0, scr, r % I_DN, lane); continue; } r -= 4 * I_DN;
        if (r < 2 * I_IN) { const int l = r / I_IN; tr_item(a.in[I_SWIN] + (size_t)l * DM * DM, DM, DM, a.in[I_MIXN] + l * DM, (bf16_t*)(ws + WS_WIN) + (size_t)l * DM * DM, DM, 0, 1, 0, scr, r % I_IN, lane); continue; } r -= 2 * I_IN;
        if (r < 2 * I_GL) { const int l = r / I_GL; tr_item(a.in[I_SGLU] + (size_t)l * DM * 2 * DM, DM, 2 * DM, nullptr, (bf16_t*)(ws + WS_WGLU) + (size_t)l * 2 * DM * DM, DM, 1, DM, 0, scr, r % I_GL, lane); continue; } r -= 2 * I_GL;
        if (r < I_QA) { tr_item(a.in[I_WQA], DM, 384, a.in[I_MIXN] + 2 * DM, (bf16_t*)(ws + WS_WQKVA), DM, 0, 1, 0, scr, r, lane); continue; } r -= I_QA;
        if (r < I_QA) { tr_item(a.in[I_WQA] + (size_t)DM * 384, DM, 384, a.in[I_MIXN] + 3 * DM, (bf16_t*)(ws + WS_WQA3), DM, 0, 1, 0, scr, r, lane); continue; } r -= I_QA;
        if (r < I_KVA) { tr_item(a.in[I_WKVA], DM, 288, a.in[I_KVINN], (bf16_t*)(ws + WS_WQKVA), DM, 0, 1, 384, scr, r, lane); continue; } r -= I_KVA;
        if (r < 2 * I_QB) { const int l = r / I_QB; tr_item(a.in[I_WQB] + (size_t)l * 384 * 1536, 384, 1536, a.in[I_QAN] + l * 384, (bf16_t*)(ws + WS_WQB) + (size_t)l * 1536 * 384, 384, 3, 1, 0, scr, r % I_QB, lane); continue; } r -= 2 * I_QB;
        if (r < I_KVB) { tr_item(a.in[I_WKVB], 256, 2048, a.in[I_KVAN], (bf16_t*)(ws + WS_WKVB), 256, 2, 1, 0, scr, r, lane); continue; } r -= I_KVB;
        { const int l = r / I_O; tr_item(a.in[I_WO] + (size_t)l * DM * DM, DM, DM, nullptr, (bf16_t*)(ws + WS_WO) + (size_t)l * DM * DM, DM, 0, 1, 0, scr, r % I_O, lane); }
    }
    { const int gt = bx * 512 + tid, NT_ = G * 512;
      u32x4* p0 = (u32x4*)((bf16_t*)(ws + WS_WQKVA) + (size_t)672 * DM); for (int i = gt; i < 96 * DM / 8; i += NT_) p0[i] = (u32x4){0u, 0u, 0u, 0u};
      u32x4* p1 = (u32x4*)((bf16_t*)(ws + WS_WQA3) + (size_t)384 * DM); for (int i = gt; i < 128 * DM / 8; i += NT_) p1[i] = (u32x4){0u, 0u, 0u, 0u};
      float* rc = (float*)(ws + WS_ROPE); float* rsn = rc + (size_t)T * 16; const int* pos = (const int*)a.in[I_POS];
      for (int i = gt; i < T * 16; i += NT_) { const int tok = i >> 4, f = i & 15; double inv = 1.0; for (int q = 0; q < f; ++q) inv *= 0.5623413251903491;
          float sn, cs; sincos_rev((double)pos[tok] * inv * 0.15915494309189535, sn, cs); rc[i] = cs; rsn[i] = sn; } }
    { const float* x = a.in[I_X]; bf16_t* xb = (bf16_t*)(ws + WS_XB); float* slots = (float*)(ws + WS_SLOT);
      for (int row = gw; row < T; row += NGW) { const f32x4* xr = (const f32x4*)(x + (size_t)row * DM) + lane; float s = 0.f;
#pragma unroll
          for (int j = 0; j < 4; ++j) { const f32x4 v = xr[64 * j]; s += (v[0] * v[0] + v[1] * v[1]) + (v[2] * v[2] + v[3] * v[3]);
              u32x2 w; w.x = cvtpk(v[0], v[1]); w.y = cvtpk(v[2], v[3]); *((u32x2*)(xb + (size_t)row * DM) + lane + 64 * j) = w; }
          s += __shfl_xor(s, 1); if ((lane & 1) == 0) slots[(size_t)row * 32 + (lane >> 1)] = s; } }
}

__device__ __forceinline__ void phase_scan(const Args& a, int layer, int tid_in) {
    const float* W = (const float*)(a.ws + WS_WST); bf16_t* Ag = (bf16_t*)(a.ws + WS_AG); const float* ac = (const float*)(a.ws + WS_AC) + (size_t)layer * 64 * 128;
    const int NTH = opq_s(gridDim.x) * 512;
    for (int gt = opq_s(blockIdx.x) * 512 + opq_v(tid_in); gt < NB * 64 * 64; gt += NTH) {
        const int n = gt & 63, g = (gt >> 6) & 63, b = gt >> 12;
        const float ar = ac[g * 128 + n], ai = ac[g * 128 + 64 + n]; float sr = 0.f, si = 0.f;
        const size_t row0 = (size_t)g * 4096 + (size_t)b * 128;
        const float* w = W + row0 * 128 + n; bf16_t* o = Ag + row0 * 384 + 256 + n;
#pragma unroll 8
        for (int m = 0; m < 128; ++m) { const float wr_ = w[(size_t)m * 128], wi_ = w[(size_t)m * 128 + 64];
            o[(size_t)m * 384] = (bf16_t)(cvtpk(sr, 0.f) & 0xffffu); o[(size_t)m * 384 + 64] = (bf16_t)(cvtpk(si, 0.f) & 0xffffu);
            const float nr = ar * sr - ai * si + wr_, ni = ar * si + ai * sr + wi_; sr = nr; si = ni; }
    }
}

__device__ __forceinline__ void phase_krope(const Args& a, int tid_in) {
    unsigned char* ws = a.ws;
    const bf16_t* qkva = (const bf16_t*)(ws + WS_QKVA); const float* slots2 = (const float*)(ws + WS_SLOT2);
    bf16_t* Kf = (bf16_t*)(ws + WS_KF); const float* rc = (const float*)(ws + WS_ROPE); const float* rsn = rc + (size_t)T * 16;
    const float* gkr = a.in[I_KROPEN];
    const int NTH = opq_s(gridDim.x) * 512;
    for (int gt = opq_s(blockIdx.x) * 512 + opq_v(tid_in); gt < T * 4; gt += NTH) { const int tok = gt >> 2, qd = gt & 3;
        const u32x2 w1 = *(const u32x2*)(qkva + (size_t)tok * 768 + 640 + 4 * qd), w2 = *(const u32x2*)(qkva + (size_t)tok * 768 + 656 + 4 * qd);
        const float r = rsqrtf(slots2[(size_t)tok * 32 + 20] * (1.0f / 32) + EPS);
        const float x1[4] = {bflo(w1.x), bfhi(w1.x), bflo(w1.y), bfhi(w1.y)}, x2[4] = {bflo(w2.x), bfhi(w2.x), bflo(w2.y), bfhi(w2.y)}; float o1[4], o2[4];
#pragma unroll
        for (int e = 0; e < 4; ++e) { const int i = 4 * qd + e; const float a1 = x1[e] * r * gkr[i], a2 = x2[e] * r * gkr[16 + i], c = rc[(size_t)tok * 16 + i], s = rsn[(size_t)tok * 16 + i];
            o1[e] = a1 * c - a2 * s; o2[e] = a1 * s + a2 * c; }
        u32x2 p1, p2; p1.x = cvtpk(o1[0], o1[1]); p1.y = cvtpk(o1[2], o1[3]); p2.x = cvtpk(o2[0], o2[1]); p2.y = cvtpk(o2[2], o2[3]);
#pragma unroll
        for (int h = 0; h < NH; ++h) { *(u32x2*)(Kf + (size_t)tok * 1536 + h * 96 + 64 + 4 * qd) = p1; *(u32x2*)(Kf + (size_t)tok * 1536 + h * 96 + 80 + 4 * qd) = p2; } }
}

__device__ __forceinline__ int crow(int r, int hi) { return (r & 3) + 8 * (r >> 2) + 4 * hi; }
constexpr int AT_KROW = 208, AT_KBUF = 64 * AT_KROW, AT_VROW = 136, AT_VBUF = 64 * AT_VROW, AT_VOFF = 2 * AT_KBUF;
template <bool FIXED>
__device__ __forceinline__ void attn_unit(LAS unsigned char* lds, const bf16_t* Q, const bf16_t* Kf, const bf16_t* Vt, bf16_t* O, int b, int h, int qb, int tid_in, float negB) {
    const int tid = opq_v(tid_in), lane = tid & 63, r32 = lane & 31, hi = lane >> 5; const int wid = __builtin_amdgcn_readfirstlane(tid >> 6);
    const int q0 = qb * 256; const size_t rowbase = (size_t)b * SEQ;
    const int qabs = q0 + wid * 32 + r32;
    bf16x8 qf[6];
    { const bf16_t* qp = Q + (rowbase + qabs) * 1536 + h * 96 + hi * 8;
#pragma unroll
      for (int s = 0; s < 6; ++s) qf[s] = *(const bf16x8*)(qp + 16 * s); }
    const int NT_ = (q0 + 256) / 64;
    const int kr0 = tid / 12, kp0 = tid % 12, kr1 = (512 + tid) / 12, kp1 = (512 + tid) % 12; const bool k2 = tid < 256;
    const bf16_t* kg0 = Kf + (rowbase + kr0) * 1536 + h * 96 + kp0 * 8;
    const bf16_t* kg1 = Kf + (rowbase + kr1) * 1536 + h * 96 + kp1 * 8;
    const int kl0 = kr0 * AT_KROW + kp0 * 16, kl1 = kr1 * AT_KROW + kp1 * 16;
    const int vd = tid >> 3, vp = tid & 7;
    const bf16_t* vg = Vt + ((size_t)(b * NH + h) * 64 + vd) * SEQ + vp * 8;
    const int vl = AT_VOFF + vd * AT_VROW + vp * 16;
    u32x4 kreg0, kreg1 = (u32x4){0u, 0u, 0u, 0u}, vreg;
    kreg0 = *(const u32x4*)kg0; if (k2) kreg1 = *(const u32x4*)kg1; vreg = *(const u32x4*)vg;
    *(LAS u32x4*)(lds + kl0) = kreg0; if (k2) *(LAS u32x4*)(lds + kl1) = kreg1;
    *(LAS u32x2*)(lds + vl) = (u32x2){vreg.x, vreg.y}; *(LAS u32x2*)(lds + vl + 8) = (u32x2){vreg.z, vreg.w};
    __syncthreads();
    float m_run = -1e30f, l_run = 0.f; f32x16 o0, o1, cinit;
#pragma unroll
    for (int r = 0; r < 16; ++r) { o0[r] = 0.f; o1[r] = 0.f; cinit[r] = FIXED ? negB : 0.f; }
    for (int t = 0; t < NT_; ++t) {
        const bool pre = (t + 1 < NT_);
        if (pre) { kreg0 = *(const u32x4*)(kg0 + (size_t)(t + 1) * 64 * 1536); if (k2) kreg1 = *(const u32x4*)(kg1 + (size_t)(t + 1) * 64 * 1536); vreg = *(const u32x4*)(vg + (t + 1) * 64); }
        const int kv0 = t * 64;
        if (kv0 <= q0 + wid * 32 + 31) {
            const LAS unsigned char* kb = lds + (t & 1) * AT_KBUF + r32 * AT_KROW + hi * 16;
            const LAS unsigned char* vb = lds + AT_VOFF + (t & 1) * AT_VBUF + r32 * AT_VROW + hi * 8;
            f32x16 s0, s1;
            { bf16x8 kf[12];
#pragma unroll
              for (int s = 0; s < 6; ++s) { kf[2 * s] = *(const LAS bf16x8*)(kb + s * 32); kf[2 * s + 1] = *(const LAS bf16x8*)(kb + 32 * AT_KROW + s * 32); }
              asm volatile("s_waitcnt lgkmcnt(0)" ::: "memory"); __builtin_amdgcn_sched_barrier(0);
#pragma unroll
              for (int s = 0; s < 6; ++s) { s0 = __builtin_amdgcn_mfma_f32_32x32x16_bf16(kf[2 * s], qf[s], s == 0 ? cinit : s0, 0, 0, 0); s1 = __builtin_amdgcn_mfma_f32_32x32x16_bf16(kf[2 * s + 1], qf[s], s == 0 ? cinit : s1, 0, 0, 0); } }
            __builtin_amdgcn_sched_barrier(0);
            u32x2 vf[16];
#pragma unroll
            for (int s = 0; s < 4; ++s) { vf[4 * s] = *(const LAS u32x2*)(vb + s * 32); vf[4 * s + 1] = *(const LAS u32x2*)(vb + s * 32 + 16);
                vf[4 * s + 2] = *(const LAS u32x2*)(vb + 32 * AT_VROW + s * 32); vf[4 * s + 3] = *(const LAS u32x2*)(vb + 32 * AT_VROW + s * 32 + 16); }
            if (kv0 + 63 > q0 + wid * 32) {
#pragma unroll
                for (int r = 0; r < 16; ++r) { const int kv = kv0 + crow(r, hi); if (kv > qabs) s0[r] = -1e30f; if (kv + 32 > qabs) s1[r] = -1e30f; }
            }
            if (FIXED) {
                float ps = 0.f;
#pragma unroll
                for (int r = 0; r < 16; ++r) { s0[r] = __builtin_amdgcn_exp2f(s0[r]); s1[r] = __builtin_amdgcn_exp2f(s1[r]); ps += s0[r] + s1[r]; }
                l_run += ps;
            } else {
                float mx = fmaxf(s0[0], s1[0]);
#pragma unroll
                for (int r = 1; r < 16; ++r) mx = fmaxf(mx, fmaxf(s0[r], s1[r]));
                mx = fmaxf(mx, __shfl_xor(mx, 32));
                const float m_new = fmaxf(m_run, mx), alpha = __builtin_amdgcn_exp2f(m_run - m_new); m_run = m_new;
                float ps = 0.f;
#pragma unroll
                for (int r = 0; r < 16; ++r) { s0[r] = __builtin_amdgcn_exp2f(s0[r] - m_new); s1[r] = __builtin_amdgcn_exp2f(s1[r] - m_new); ps += s0[r] + s1[r]; }
                l_run = l_run * alpha + ps;
#pragma unroll
                for (int r = 0; r < 16; ++r) { o0[r] *= alpha; o1[r] *= alpha; }
            }
            bf16x8 pk[4];
#pragma unroll
            for (int s = 0; s < 4; ++s) { u32x4 w;
#pragma unroll
                for (int e = 0; e < 4; ++e) { const int r = 8 * (s & 1) + 2 * e; w[e] = (s < 2) ? cvtpk(s0[r], s0[r + 1]) : cvtpk(s1[r], s1[r + 1]); }
                pk[s] = __builtin_bit_cast(bf16x8, w); }
            asm volatile("s_waitcnt lgkmcnt(0)" ::: "memory"); __builtin_amdgcn_sched_barrier(0);
#pragma unroll
            for (int s = 0; s < 4; ++s) {
                { const u32x4 w = (u32x4){vf[4 * s].x, vf[4 * s].y, vf[4 * s + 1].x, vf[4 * s + 1].y}; o0 = __builtin_amdgcn_mfma_f32_32x32x16_bf16(__builtin_bit_cast(bf16x8, w), pk[s], o0, 0, 0, 0); }
                { const u32x4 w = (u32x4){vf[4 * s + 2].x, vf[4 * s + 2].y, vf[4 * s + 3].x, vf[4 * s + 3].y}; o1 = __builtin_amdgcn_mfma_f32_32x32x16_bf16(__builtin_bit_cast(bf16x8, w), pk[s], o1, 0, 0, 0); }
            }
        }
        if (pre) { const int bo = ((t + 1) & 1); *(LAS u32x4*)(lds + bo * AT_KBUF + kl0) = kreg0; if (k2) *(LAS u32x4*)(lds + bo * AT_KBUF + kl1) = kreg1;
            *(LAS u32x2*)(lds + bo * AT_VBUF + vl) = (u32x2){vreg.x, vreg.y}; *(LAS u32x2*)(lds + bo * AT_VBUF + vl + 8) = (u32x2){vreg.z, vreg.w}; }
        __syncthreads();
    }
    const float lt = l_run + __shfl_xor(l_run, 32), inv = 1.0f / lt;
    bf16_t* op = O + (rowbase + qabs) * DM + h * 64 + 4 * hi;
#pragma unroll
    for (int g = 0; g < 4; ++g) { u32x2 w; w.x = cvtpk(o0[4 * g] * inv, o0[4 * g + 1] * inv); w.y = cvtpk(o0[4 * g + 2] * inv, o0[4 * g + 3] * inv); *(u32x2*)(op + 8 * g) = w;
        u32x2 w2; w2.x = cvtpk(o1[4 * g] * inv, o1[4 * g + 1] * inv); w2.y = cvtpk(o1[4 * g + 2] * inv, o1[4 * g + 3] * inv); *(u32x2*)(op + 32 + 8 * g) = w2; }
}
__device__ __forceinline__ float wave_max(float v) {
#pragma unroll
    for (int o = 1; o < 64; o <<= 1) v = fmaxf(v, __shfl_xor(v, o));
    return v;
}
__device__ __forceinline__ void phase_attn(const Args& a, LAS unsigned char* lds, int tid_in, int j) {
    const bf16_t* Q = (const bf16_t*)(a.ws + WS_QRAW); const bf16_t* Kf = (const bf16_t*)(a.ws + WS_KF); const bf16_t* Vt = (const bf16_t*)(a.ws + WS_VT); bf16_t* O = (bf16_t*)(a.ws + WS_O);
    float B;
    { const int lane = opq_v(tid_in) & 63;
      const float gqn = wave_max(fabsf(a.in[I_QNOPEN][j * 64 + lane])), gkn = wave_max(fabsf(a.in[I_KNOPEN][lane]));
      const float gqr = wave_max(fabsf(a.in[I_QROPEN][j * 32 + (lane & 31)])), gkr = wave_max(fabsf(a.in[I_KROPEN][lane & 31]));
      B = sqrtf(64.f * gqn * gqn + 32.f * gqr * gqr) * sqrtf(64.f * gkn * gkn + 32.f * gkr * gkr) * QSCALE * 1.02f; }
    const bool fixed = (B <= 40.0f);
    const int G = opq_s(gridDim.x), bx = opq_s(blockIdx.x); const int vcu = (G % 8 == 0) ? (bx % 8) * (G / 8) + bx / 8 : bx;
    for (int p = vcu; p < NB * NH * 4; p += G) {
        const int bh = p >> 2, s = p & 3;
        if (fixed) { attn_unit<true>(lds, Q, Kf, Vt, O, bh / NH, bh % NH, 7 - s, tid_in, -B); attn_unit<true>(lds, Q, Kf, Vt, O, bh / NH, bh % NH, s, tid_in, -B); }
        else { attn_unit<false>(lds, Q, Kf, Vt, O, bh / NH, bh % NH, 7 - s, tid_in, 0.f); attn_unit<false>(lds, Q, Kf, Vt, O, bh / NH, bh % NH, s, tid_in, 0.f); }
    }
}

#define XB_TMO      128
#define XB_XCNT(j)  (256  + 64 * (j))
#define XB_XSUB(j)  (1280 + 64 * (j))
#define XB_XGEN(j)  (2304 + 64 * (j))
#define XB_TOP      3328
#define XB_TOPGEN   3392
#define XCD_BAR_WORDS 3456
#define XB_SPIN_CAP (1u << 18)

__device__ __forceinline__ unsigned xb_ld(unsigned* p)              { return __hip_atomic_load(p, __ATOMIC_RELAXED, __HIP_MEMORY_SCOPE_AGENT); }
__device__ __forceinline__ unsigned xb_add(unsigned* p, unsigned v) { return __hip_atomic_fetch_add(p, v, __ATOMIC_RELAXED, __HIP_MEMORY_SCOPE_AGENT); }
__device__ __forceinline__ unsigned xb_xcc_id() { return (unsigned)__builtin_amdgcn_s_getreg((3 << 11) | 20) & 0xFu; }
#define XB_SPIN(cond, bar) do { unsigned _sp = 0; while (cond) { __builtin_amdgcn_s_sleep(1); \
    if ((++_sp & 255u) == 0u) { if (xb_ld(&(bar)[XB_TMO])) break; if (_sp > XB_SPIN_CAP) { atomicAdd(&(bar)[XB_TMO], 1u); break; } } } } while (0)

struct XcdBarrier {
    unsigned* bar; unsigned x;
    volatile LAS unsigned* st;
};

__device__ __forceinline__ XcdBarrier xcd_barrier_post(unsigned* bar, volatile LAS unsigned* st) {
    XcdBarrier b; b.bar = bar; b.x = xb_xcc_id(); b.st = st;
    if (threadIdx.x == 0) (void)xb_add(&bar[XB_XCNT(b.x)], 1u);
    return b;
}
__device__ __forceinline__ void xcd_barrier_complete(unsigned* bar, unsigned x, unsigned& nloc, unsigned& nx) {
    const unsigned G = gridDim.x * gridDim.y * gridDim.z;
    unsigned sum, cnt, mine, sp = 0u;
    for (;;) {
        sum = 0u; cnt = 0u; mine = 0u;
#pragma unroll
        for (unsigned j = 0; j < 16; ++j) { const unsigned c = xb_ld(&bar[XB_XCNT(j)]); sum += c; cnt += (c > 0u) ? 1u : 0u; mine = (j == x) ? c : mine; }
        if (sum == G) break;
        __builtin_amdgcn_s_sleep(1);
        if ((++sp & 255u) == 0u) { if (xb_ld(&bar[XB_TMO])) break; if (sp > XB_SPIN_CAP) { atomicAdd(&bar[XB_TMO], 1u); break; } }
    }
    nloc = mine > 0u ? mine : 1u; nx = cnt > 0u ? cnt : 1u;
}

__device__ __forceinline__ void xcd_barrier(const XcdBarrier& b, int tid_in) {
    asm volatile("s_waitcnt vmcnt(0)" ::: "memory");
    __syncthreads();
    if (tid_in == 0) {
        unsigned* bar = b.bar; asm volatile("" : "+s"(bar));
        __builtin_amdgcn_s_waitcnt(0);
        unsigned nloc = b.st[0], nx = b.st[1];
        if (nloc == 0u) { xcd_barrier_complete(bar, b.x, nloc, nx); b.st[0] = nloc; b.st[1] = nx; }
        const unsigned old = xb_add(&bar[XB_XSUB(b.x)], 1u);
        const unsigned gen = old / nloc;
        if (old + 1u == (gen + 1u) * nloc) {
            __builtin_amdgcn_fence(__ATOMIC_RELEASE, "agent");
            asm volatile("s_waitcnt vmcnt(0)" ::: "memory");
            const unsigned og = xb_add(&bar[XB_TOP], 1u);
            const unsigned tg = og / nx;
            if (og + 1u == (tg + 1u) * nx) xb_add(&bar[XB_TOPGEN], 1u);
            else XB_SPIN(xb_ld(&bar[XB_TOPGEN]) == tg, bar);
            __builtin_amdgcn_fence(__ATOMIC_ACQUIRE, "agent");
            xb_add(&bar[XB_XGEN(b.x)], 1u);
            asm volatile("s_waitcnt vmcnt(0)" ::: "memory");
        } else {
            XB_SPIN(xb_ld(&bar[XB_XGEN(b.x)]) == gen, bar);
            __builtin_amdgcn_fence(__ATOMIC_ACQUIRE, "agent");
            asm volatile("s_waitcnt vmcnt(0)" ::: "memory");
        }
    }
    __syncthreads();
}

#ifndef PHMASK
#define PHMASK 0xFFFFFFFFu
#endif
#define EN(k) (((PHMASK) >> (k)) & 1u)
#ifndef REPMASK
#define REPMASK 0u
#endif
#define REP(k) (((REPMASK) >> (k)) & 1u)
constexpr int LDS_BYTES = 131072 + 256;
#if defined(__HIP_DEVICE_COMPILE__)
typedef const __attribute__((address_space(4))) Args* kargs_t;
#else
typedef const Args* kargs_t;
#endif
__device__ __forceinline__ kargs_t args_ptr() {
    unsigned long long v = (unsigned long long)__builtin_amdgcn_kernarg_segment_ptr(); asm volatile("" : "+s"(v)); return (kargs_t)v;
}
__global__ void __launch_bounds__(512, 2) yoco_fwd(Args a0) {
    extern __shared__ __attribute__((aligned(16))) unsigned char lds_raw[];
    LAS unsigned char* lds = (LAS unsigned char*)lds_raw;
    cg::grid_group grid = cg::this_grid();
    const int G = gridDim.x, bx = blockIdx.x;
    const int s_wid = __builtin_amdgcn_readfirstlane((int)threadIdx.x >> 6);
#define TIDV ((s_wid << 6) | lane_id_opq())
    if (threadIdx.x < 64) ((LAS unsigned*)(lds + 131072))[threadIdx.x] = 0u;
    __syncthreads();
    XcdBarrier xbar = xcd_barrier_post((unsigned*)(a0.ws + WS_BAR), (volatile LAS unsigned*)(lds + 131072));
#define GRID_SYNC() xcd_barrier(xbar, TIDV)
#define PHASE_BEGIN(k) { for (int rep_ = 0; rep_ <= (int)REP(k); ++rep_) { if (rep_) GRID_SYNC(); const Args a = *args_ptr(); unsigned char* ws = a.ws; bf16_t* xb = (bf16_t*)(ws + WS_XB); float* slots = (float*)(ws + WS_SLOT); float* slots2 = (float*)(ws + WS_SLOT2); (void)xb; (void)slots; (void)slots2;
#define PHASE_END   } GRID_SYNC(); }
#define PHASE_END_LAST(cond) } if (cond) GRID_SYNC(); }
    using namespace pg8;
#ifdef EXTRA_SYNCS
    for (int i_ = 0; i_ < EXTRA_SYNCS; ++i_) GRID_SYNC();
#endif
    PHASE_BEGIN(0) phase_setup(a, lds, TIDV); } grid.sync(); }
#pragma unroll 1
    for (int layer = 0; layer < 4; ++layer) {
        if (layer < 2) {
            PHASE_BEGIN(1) { Gemm g{xb, (const bf16_t*)(ws + WS_WIN) + (size_t)layer * DM * DM, DM, DM, DM, 0, 0}; Sched S; S.init(T, DM, 1, opq_s(G), opq_s(bx));
                EpiScaleBf16<1, false> E{(bf16_t*)(ws + WS_AG), 0, RowScale{slots, 0, 8, 1.0f / DM}, nullptr}; gemm_phase<EpiScaleBf16<1, false>, true>(lds, g, S, E, TIDV); } PHASE_END
            PHASE_BEGIN(2) { Gemm g{(const bf16_t*)(ws + WS_AG), (const bf16_t*)(ws + WS_BTP) + (size_t)layer * 64 * 256 * 256, 256, 384, 256, 4096L * 384, 256L * 256}; Sched S; S.init(4096, 256, 64, opq_s(G), opq_s(bx));
                EpiSsmP E{(float*)(ws + WS_WST)}; gemm_phase<EpiSsmP, true>(lds, g, S, E, TIDV); } PHASE_END
            PHASE_BEGIN(3) phase_scan(a, layer, TIDV); PHASE_END
            PHASE_BEGIN(4) { Gemm g{(const bf16_t*)(ws + WS_AG), (const bf16_t*)(ws + WS_BTY) + (size_t)layer * 64 * 256 * 384, 384, 384, 384, 4096L * 384, 256L * 384}; Sched S; S.init(4096, 256, 64, opq_s(G), opq_s(bx));
                EpiSsmY E{(const bf16_t*)(ws + WS_AG), a.in[I_SD] + layer * DM, (bf16_t*)(ws + WS_Z)}; gemm_phase<EpiSsmY, true>(lds, g, S, E, TIDV); } PHASE_END
            PHASE_BEGIN(5) { Gemm g{(const bf16_t*)(ws + WS_Z), (const bf16_t*)(ws + WS_WGLU) + (size_t)layer * 2 * DM * DM, DM, DM, DM, 0, 0}; Sched S; S.init(T, 2 * DM, 1, opq_s(G), opq_s(bx));
                EpiRes<true> E{a.out, xb, slots, false}; gemm_phase<EpiRes<true>, true>(lds, g, S, E, TIDV); } PHASE_END
        } else {
            const int j = layer - 2;
            if (j == 0) {
                PHASE_BEGIN(6) { Gemm g{xb, (const bf16_t*)(ws + WS_WQKVA), DM, DM, DM, 0, 0}; Sched S; S.init(T, 768, 1, opq_s(G), opq_s(bx));
                    EpiScaleBf16<0, true> E{(bf16_t*)(ws + WS_QKVA), 768, RowScale{slots, 0, 8, 1.0f / DM}, slots2}; gemm_phase<EpiScaleBf16<0, true>, true>(lds, g, S, E, TIDV); } PHASE_END
                PHASE_BEGIN(7) { phase_krope(a, TIDV);
                    { Gemm g{(const bf16_t*)(ws + WS_QKVA) + 384, (const bf16_t*)(ws + WS_WKVB), 256, 768, 256, 0, 0}; Sched S; S.init(T, 1024, 1, opq_s(G), opq_s(bx));
                      EpiHead E{(bf16_t*)(ws + WS_KF), RowScale{slots2, 12, 2, 1.0f / 256}, a.in[I_KNOPEN], nullptr, nullptr, nullptr, 1.0f}; gemm_phase<EpiHead, true>(lds, g, S, E, TIDV); }
                    { Gemm g{(const bf16_t*)(ws + WS_WKVB) + (size_t)1024 * 256, (const bf16_t*)(ws + WS_QKVA) + 384, 256, 256, 768, 0, 0}; Sched S; S.init(1024, T, 1, opq_s(G), opq_s(bx));
                      EpiVt E{(bf16_t*)(ws + WS_VT), slots2}; gemm_phase<EpiVt, true>(lds, g, S, E, TIDV); }
                    { Gemm g{(const bf16_t*)(ws + WS_QKVA), (const bf16_t*)(ws + WS_WQB), 384, 768, 384, 0, 0}; Sched S; S.init(T, 1536, 1, opq_s(G), opq_s(bx));
                      EpiHead E{(bf16_t*)(ws + WS_QRAW), RowScale{slots2, 0, 3, 1.0f / 384}, a.in[I_QNOPEN], a.in[I_QROPEN], (const float*)(ws + WS_ROPE), (const float*)(ws + WS_ROPE) + (size_t)T * 16, QSCALE}; gemm_phase<EpiHead, true>(lds, g, S, E, TIDV); } } PHASE_END
            } else {
                PHASE_BEGIN(10) { Gemm g{xb, (const bf16_t*)(ws + WS_WQA3), DM, DM, DM, 0, 0}; Sched S; S.init(T, 512, 1, opq_s(G), opq_s(bx));
                    EpiScaleBf16<0, true> E{(bf16_t*)(ws + WS_QKVA), 512, RowScale{slots, 0, 8, 1.0f / DM}, slots2}; gemm_phase<EpiScaleBf16<0, true>, true>(lds, g, S, E, TIDV); } PHASE_END
                PHASE_BEGIN(11) { Gemm g{(const bf16_t*)(ws + WS_QKVA), (const bf16_t*)(ws + WS_WQB) + (size_t)1536 * 384, 384, 512, 384, 0, 0}; Sched S; S.init(T, 1536, 1, opq_s(G), opq_s(bx));
                    EpiHead E{(bf16_t*)(ws + WS_QRAW), RowScale{slots2, 0, 3, 1.0f / 384}, a.in[I_QNOPEN] + 64, a.in[I_QROPEN] + 32, (const float*)(ws + WS_ROPE), (const float*)(ws + WS_ROPE) + (size_t)T * 16, QSCALE}; gemm_phase<EpiHead, true>(lds, g, S, E, TIDV); } PHASE_END
            }
            PHASE_BEGIN(13) phase_attn(a, lds, TIDV, j); PHASE_END
            PHASE_BEGIN(14) { Gemm g{(const bf16_t*)(ws + WS_O), (const bf16_t*)(ws + WS_WO) + (size_t)j * DM * DM, DM, DM, DM, 0, 0}; Sched S; S.init(T, DM, 1, opq_s(G), opq_s(bx));
                EpiRes<false> E{a.out, xb, slots, false}; gemm_phase<EpiRes<false>, true>(lds, g, S, E, TIDV); } PHASE_END
        }
        PHASE_BEGIN(15) { Gemm g{xb, (const bf16_t*)(ws + WS_WGU) + (size_t)layer * 2 * FF * DM, DM, DM, DM, 0, 0}; Sched S; S.init(T, 2 * FF, 1, opq_s(G), opq_s(bx));
            EpiSwiGLU E{(bf16_t*)(ws + WS_FFA), RowScale{slots, 0, 8, 1.0f / DM}}; gemm_phase<EpiSwiGLU, true>(lds, g, S, E, TIDV); } PHASE_END
        PHASE_BEGIN(16) { Gemm g{(const bf16_t*)(ws + WS_FFA), (const bf16_t*)(ws + WS_WDN) + (size_t)layer * DM * FF, FF, FF, FF, 0, 0}; Sched S; S.init(T, DM, 1, opq_s(G), opq_s(bx));
            EpiRes<false> E{a.out, xb, slots, layer == 3}; gemm_phase<EpiRes<false>, true>(lds, g, S, E, TIDV); } PHASE_END_LAST(layer < 3)
    }
}

extern "C" void kernel_launch(void* const* d_in, const int* in_sizes, int n_in, void* d_out, int out_size, void* d_ws, size_t ws_size, hipStream_t stream) {
    static int grid = 0;
    if (grid == 0) {
        if (n_in != N_IN || out_size != T * DM || ws_size < WS_END) { fprintf(stderr, "kernel_launch: unexpected shapes (n_in %d out %d ws %zu)\n", n_in, out_size, ws_size); grid = -1; return; }
        int dev = 0, cus = 0, per = 0;
        (void)hipGetDevice(&dev); (void)hipDeviceGetAttribute(&cus, hipDeviceAttributeMultiprocessorCount, dev);
        (void)hipFuncSetAttribute((const void*)yoco_fwd, hipFuncAttributeMaxDynamicSharedMemorySize, LDS_BYTES);
        (void)hipOccupancyMaxActiveBlocksPerMultiprocessor(&per, (const void*)yoco_fwd, 512, LDS_BYTES);
        if (per < 1) per = 1;
        grid = cus * per;
        fprintf(stderr, "kernel_launch: grid %d (cus %d x %d)\n", grid, cus, per);
    }
    if (grid < 0) return;
    (void)hipMemsetAsync((unsigned char*)d_ws + WS_BAR, 0, WS_BAR_BYTES, stream);
    Args a{};
    for (int i = 0; i < N_IN; ++i) a.in[i] = (const float*)d_in[i];
    a.out = (float*)d_out; a.ws = (unsigned char*)d_ws; a.ph_lo = 0; a.ph_hi = 1000;
    void* args[] = {&a};
    hipError_t e = hipLaunchCooperativeKernel((const void*)yoco_fwd, dim3(grid), dim3(512), args, LDS_BYTES, stream);
    if (e != hipSuccess) fprintf(stderr, "kernel_launch: cooperative launch failed: %s (grid %d)\n", hipGetErrorString(e), grid);
}
```

```cpp
#include <hip/hip_runtime.h>
#include <hip/hip_cooperative_groups.h>
#include <cstdio>
#include <cstdint>
namespace cg = cooperative_groups;

#define LAS __attribute__((address_space(3)))
typedef unsigned short bf16_t;
typedef short bf16x8 __attribute__((ext_vector_type(8)));
typedef float f32x4 __attribute__((ext_vector_type(4)));
typedef float f32x16 __attribute__((ext_vector_type(16)));
typedef unsigned u32x4 __attribute__((ext_vector_type(4)));
typedef unsigned u32x2 __attribute__((ext_vector_type(2)));
typedef float f32x2_t __attribute__((ext_vector_type(2)));
typedef __bf16 bf16x2_t __attribute__((ext_vector_type(2)));

constexpr int T = 65536, DM = 1024, SEQ = 2048, NB = 32, FF = 2816, NH = 16;
constexpr float EPS = 1e-6f;
constexpr float QSCALE = 0.14724444f;

constexpr size_t MiB = 1u << 20;
constexpr size_t WS_WIN = 0, WS_WGLU = 4 * MiB, WS_WGU = 12 * MiB, WS_WDN = 56 * MiB, WS_WQKVA = 78 * MiB, WS_WQA3 = 80 * MiB,
                 WS_WQB = 81 * MiB, WS_WKVB = 84 * MiB, WS_WO = 85 * MiB, WS_BTY = 90 * MiB, WS_BTP = 114 * MiB, WS_AC = 130 * MiB,
                 WS_ROPE = 131 * MiB, WS_SLOT = 139 * MiB, WS_SLOT2 = 147 * MiB, WS_XB = 155 * MiB,
                 WS_KF = 283 * MiB, WS_VT = 475 * MiB, WS_R = 603 * MiB, WS_END = 1024 * MiB;
constexpr size_t WS_BAR = 130 * MiB + 512 * 1024, WS_BAR_GRP = 16384, WS_BAR_BYTES = 8 * WS_BAR_GRP;
constexpr size_t SLICE0 = 283 * MiB, SLICE = (741 * MiB) / 8, GTOK = 8192;
constexpr size_t L_KF = 0, L_AG = 0, L_VT = 24 * MiB, L_WST = 24 * MiB, L_R = 40 * MiB, L_FFA = L_R, L_Z = L_R, L_QRAW = L_R, L_O = L_R + 24 * MiB + 512 * 1024, L_QKVA = L_R + 37 * MiB + 512 * 1024;
__host__ __device__ __forceinline__ size_t voff(int gx, size_t loff, size_t rowbytes) { return SLICE0 + loff + (size_t)gx * (SLICE - GTOK * rowbytes); }
__host__ __device__ __forceinline__ size_t loff_(int gx, size_t loff) { return SLICE0 + loff + (size_t)gx * SLICE; }

enum { I_X = 0, I_POS, I_MIXN, I_FFNN, I_WGU, I_WDN, I_SWIN, I_LRE, I_LIM, I_LSTEP, I_BRE, I_BIM, I_CRE, I_CIM, I_SD, I_SGLU,
       I_KVINN, I_WKVA, I_KVAN, I_WKVB, I_KNOPEN, I_KROPEN, I_WQA, I_QAN, I_WQB, I_QNOPEN, I_QROPEN, I_WO, N_IN };

__device__ __forceinline__ int opq_v(int v) { asm volatile("" : "+v"(v)); return v; }
__device__ __forceinline__ int opq_s(int v) { asm volatile("" : "+s"(v)); return v; }
__device__ __forceinline__ int lane_id_opq() { unsigned z = 0u; asm volatile("" : "+v"(z)); return (int)__builtin_amdgcn_mbcnt_hi(~0u, __builtin_amdgcn_mbcnt_lo(~0u, z)); }
__device__ __forceinline__ unsigned cvtpk(float lo, float hi) { f32x2_t v = {lo, hi}; bf16x2_t b = __builtin_convertvector(v, bf16x2_t); return __builtin_bit_cast(unsigned, b); }
__device__ __forceinline__ float bflo(unsigned w) { return __uint_as_float(w << 16); }
__device__ __forceinline__ float bfhi(unsigned w) { return __uint_as_float(w & 0xffff0000u); }
__device__ __forceinline__ float sigmoidf_(float x) { return __builtin_amdgcn_rcpf(1.0f + __builtin_amdgcn_exp2f(-1.4426950408889634f * x)); }
__device__ __forceinline__ float gelu_tanh(float x) { const float u = 1.5957691216057308f * (x + 0.044715f * x * x * x); return x * sigmoidf_(u); }

namespace pg8 {
constexpr int BM = 256, BK = 64, HALF = 128, HTB = HALF * BK * 2, STAGE_BYTES = 8 * HTB, NXCD = 8, WGM = 8;
__host__ __device__ __forceinline__ int lds_byte(int r, int c) { const int st = (r >> 4) * 2 + (c >> 5), rr = r & 15, cc = c & 31, ob = rr * 64 + cc * 2; return st * 1024 + (ob ^ (((ob >> 9) & 1) << 5)); }
__host__ __device__ __forceinline__ void stage_rc(int b, int& R, int& C) { const int st = b / 1024, sb = b % 1024, swz = sb ^ (((sb >> 9) & 1) << 5); R = (st >> 1) * 16 + swz / 64; C = (st & 1) * 32 + (swz % 64) / 2; }
__host__ __device__ __forceinline__ int perm32(int rho) { const int n = rho >> 4, i = rho & 15; return 8 * (i >> 2) + 4 * n + (i & 3); }

struct Unit { int pm, pn, pg; };
struct Gemm { const bf16_t* A; const bf16_t* Bt; int K, lda, ldb; long gsA, gsB; };

struct Sched {
    int nM, nN, nwg, nG, G, c, mode;
    __device__ void init(int M, int N, int nG_, int G_, int c_) { nM = M / BM; nN = N / BM; nwg = nM * nN; nG = nG_; G = G_; c = c_; mode = 0; }
    __device__ void init_local(int mode_, int c_) { nM = nN = nwg = nG = 1; G = 256; c = c_; mode = mode_; }
    __device__ bool next(int i, Unit& u) const {
        if (mode == 1) { if (i >= 4) return false; const int j = (c >> 3) + 32 * i; u.pg = j >> 1; u.pm = j & 1; u.pn = 0; return true; }
        if (mode == 2) { if (i >= 4) return false; const int j = (c >> 3) + 32 * i; u.pg = 0; u.pm = j & 3; u.pn = 32 * (c & 7) + (j >> 2); return true; }
        const long L = (long)i * G + c; if (L >= (long)nwg * nG) return false;
        u.pg = (int)(L / nwg); int wgid = (int)(L % nwg);
        { const int q = nwg / NXCD, r = nwg % NXCD, xcd = wgid % NXCD, off = wgid / NXCD; wgid = (xcd < r ? xcd * (q + 1) : r * (q + 1) + (xcd - r) * q) + off; }
        const int nig = WGM * nN, gid = wgid / nig, fm = gid * WGM, gsz = (nM - fm) < WGM ? (nM - fm) : WGM;
        u.pm = fm + ((wgid % nig) % gsz); u.pn = (wgid % nig) / gsz; return true;
    }
};

template <class Epi, bool ALIGN_EPI>
__device__ __forceinline__ void gemm_phase(LAS unsigned char* lds, const Gemm g, const Sched& S, const Epi& E, int tid_in) {
    int tid_ = tid_in; asm volatile("" : "+v"(tid_));
    const int tid = tid_, wid = __builtin_amdgcn_readfirstlane(tid >> 6), lane = tid & 63, wr = wid >> 2, wc = wid & 3, fr = lane & 15, fq = lane >> 4;
    const int K = g.K, nt = K / BK;
    unsigned voffA[2], voffB[2];
#pragma unroll
    for (int i = 0; i < 2; ++i) { int R, C; stage_rc(tid * 16 + i * 8192, R, C); const int Rb = (R & ~31) + perm32(R & 31);
        voffA[i] = (unsigned)(R * g.lda + C) * 2u; voffB[i] = (unsigned)(Rb * g.ldb + C) * 2u; }
    const size_t kstep = (size_t)(BK * 2);
    const size_t hsA = (size_t)HALF * g.lda * 2, hsB = (size_t)HALF * g.ldb * 2;
    const size_t tsA = 2 * hsA, tsB = 2 * hsB;
    const unsigned ldsw = (unsigned)wid * 1024u;
    const int aoff = lds_byte(wr * 64 + fr, fq * 8), boff = lds_byte(wc * 32 + fr, fq * 8);
#define PG8_SA(b, h) (((b) * 2 + (h)) * HTB)
#define PG8_SB(b, h) ((4 + (b) * 2 + (h)) * HTB)
#define PG8_STAGE(bufoff, gbase, voff) do { _Pragma("unroll") for (int _i = 0; _i < 2; ++_i) \
        __builtin_amdgcn_global_load_lds((const unsigned*)((const char*)(gbase) + (voff)[_i]), (LAS unsigned*)(lds + (bufoff) + ldsw + _i * 8192), 16, 0, 0); } while (0)
#define PG8_LDA(dst, b, h) do { _Pragma("unroll") for (int m = 0; m < 4; ++m) _Pragma("unroll") for (int k = 0; k < 2; ++k) dst[m][k] = *(const LAS bf16x8*)(lds + PG8_SA(b, h) + aoff + m * 2048 + k * 1024); } while (0)
#define PG8_LDB(dst, b, h) do { _Pragma("unroll") for (int n = 0; n < 2; ++n) _Pragma("unroll") for (int k = 0; k < 2; ++k) dst[n][k] = *(const LAS bf16x8*)(lds + PG8_SB(b, h) + boff + n * 2048 + k * 1024); } while (0)
#define PG8_MMA(ai, bj, At, Bt) do { __builtin_amdgcn_s_setprio(1); _Pragma("unroll") for (int m = 0; m < 4; ++m) _Pragma("unroll") for (int n = 0; n < 2; ++n) _Pragma("unroll") for (int k = 0; k < 2; ++k) \
        acc[ai][bj][m][n] = __builtin_amdgcn_mfma_f32_16x16x32_bf16(Bt[n][k], At[m][k], acc[ai][bj][m][n], 0, 0, 0); __builtin_amdgcn_s_setprio(0); } while (0)
#define PG8_WAIT_V(n) asm volatile("s_waitcnt vmcnt(" #n ")" ::: "memory")
#define PG8_WAIT_L(n) asm volatile("s_waitcnt lgkmcnt(" #n ")" ::: "memory")
#define PG8_BAR __builtin_amdgcn_s_barrier()
#define PG8_SCHED __builtin_amdgcn_sched_barrier(0)
    Unit cur, nxt; int ui = 0;
    if (!S.next(0, cur)) return;
    f32x4 acc[2][2][4][2];
#pragma unroll
    for (int a = 0; a < 2; ++a)
#pragma unroll
        for (int b = 0; b < 2; ++b)
#pragma unroll
            for (int m = 0; m < 4; ++m)
#pragma unroll
                for (int n = 0; n < 2; ++n) acc[a][b][m][n] = (f32x4){0.f, 0.f, 0.f, 0.f};
    bf16x8 At[4][2], B0[2][2], B1[2][2];
    const char* cA = (const char*)(g.A + (size_t)cur.pg * g.gsA) + (size_t)cur.pm * tsA;
    const char* cB = (const char*)(g.Bt + (size_t)cur.pg * g.gsB) + (size_t)cur.pn * tsB;
    PG8_STAGE(PG8_SB(0, 0), cB, voffB); PG8_STAGE(PG8_SB(0, 1), cB + hsB, voffB); PG8_STAGE(PG8_SA(0, 0), cA, voffA); PG8_STAGE(PG8_SA(0, 1), cA + hsA, voffA);
    if (wr == 1) PG8_BAR;
    PG8_WAIT_V(2); PG8_BAR;
    PG8_STAGE(PG8_SB(1, 0), cB + kstep, voffB); PG8_STAGE(PG8_SA(1, 0), cA + kstep, voffA); PG8_STAGE(PG8_SB(1, 1), cB + hsB + kstep, voffB);
    PG8_WAIT_V(6); PG8_BAR;
    for (;;) {
        const bool has_next = S.next(ui + 1, nxt);
        const char* nA = has_next ? (const char*)(g.A + (size_t)nxt.pg * g.gsA) + (size_t)nxt.pm * tsA : cA;
        const char* nB = has_next ? (const char*)(g.Bt + (size_t)nxt.pg * g.gsB) + (size_t)nxt.pn * tsB : cB;
        for (int t = 0; t < nt; t += 2) {
            const bool last = (t == nt - 2);
            const char* a1 = cA + (size_t)(t + 1) * kstep;
            const char* a2 = last ? nA : cA + (size_t)(t + 2) * kstep; const char* b2 = last ? nB : cB + (size_t)(t + 2) * kstep;
            const char* a3 = a2 + kstep; const char* b3 = b2 + kstep;
            PG8_LDB(B0, 0, 0); PG8_LDB(B1, 0, 1); PG8_SCHED; PG8_LDA(At, 0, 0); PG8_STAGE(PG8_SA(1, 1), a1 + hsA, voffA);
            PG8_WAIT_V(8); PG8_WAIT_L(0); PG8_BAR; PG8_MMA(0, 0, At, B0); PG8_MMA(0, 1, At, B1); PG8_BAR; PG8_SCHED;
            PG8_LDA(At, 0, 1); PG8_STAGE(PG8_SB(0, 0), b2, voffB); PG8_STAGE(PG8_SB(0, 1), b2 + hsB, voffB); PG8_STAGE(PG8_SA(0, 0), a2, voffA);
            PG8_WAIT_V(8); PG8_WAIT_L(0); PG8_BAR; PG8_MMA(1, 0, At, B0); PG8_MMA(1, 1, At, B1); PG8_BAR; PG8_SCHED;
            PG8_LDB(B0, 1, 0); PG8_LDB(B1, 1, 1); PG8_SCHED; PG8_LDA(At, 1, 0); PG8_STAGE(PG8_SA(0, 1), a2 + hsA, voffA);
            PG8_WAIT_V(8); PG8_WAIT_L(0); PG8_BAR; PG8_MMA(0, 0, At, B0); PG8_MMA(0, 1, At, B1); PG8_BAR; PG8_SCHED;
            PG8_LDA(At, 1, 1); PG8_STAGE(PG8_SB(1, 0), b3, voffB); PG8_STAGE(PG8_SB(1, 1), b3 + hsB, voffB); PG8_STAGE(PG8_SA(1, 0), a3, voffA);
            PG8_WAIT_V(8); PG8_WAIT_L(0); PG8_BAR; PG8_MMA(1, 0, At, B0); PG8_MMA(1, 1, At, B1); PG8_BAR; PG8_SCHED;
        }
        if constexpr (ALIGN_EPI) { if (wr == 0) PG8_BAR; }
        E(acc, cur, wr, wc, fr, fq);
        if (!has_next) break;
#pragma unroll
        for (int a = 0; a < 2; ++a)
#pragma unroll
            for (int b = 0; b < 2; ++b)
#pragma unroll
                for (int m = 0; m < 4; ++m)
#pragma unroll
                    for (int n = 0; n < 2; ++n) acc[a][b][m][n] = (f32x4){0.f, 0.f, 0.f, 0.f};
        cur = nxt; cA = nA; cB = nB; ++ui;
        if constexpr (ALIGN_EPI) { if (wr == 1) PG8_BAR; }
    }
    PG8_WAIT_V(0);
    if constexpr (!ALIGN_EPI) { if (wr == 0) PG8_BAR; }
    PG8_BAR;
#undef PG8_SA
#undef PG8_SB
#undef PG8_STAGE
#undef PG8_LDA
#undef PG8_LDB
#undef PG8_MMA
#undef PG8_WAIT_V
#undef PG8_WAIT_L
#undef PG8_BAR
#undef PG8_SCHED
}

struct RowScale {
    const float* slots; int s0, npf; float inv_n;
    __device__ __forceinline__ float get(int row, int fq) const {
        const float* p = slots + (size_t)row * 32 + s0 + fq * npf; float s = 0.f;
        for (int i = 0; i < npf; ++i) s += p[i];
        s += __shfl_xor(s, 16); s += __shfl_xor(s, 32);
        return rsqrtf(s * inv_n + EPS);
    }
};
__device__ __forceinline__ float ssq8(const f32x4& a, const f32x4& b) { return (a[0] * a[0] + a[1] * a[1]) + (a[2] * a[2] + a[3] * a[3]) + (b[0] * b[0] + b[1] * b[1]) + (b[2] * b[2] + b[3] * b[3]); }
__device__ __forceinline__ u32x4 pack8(const f32x4& a, const f32x4& b) { u32x4 w; w.x = cvtpk(a[0], a[1]); w.y = cvtpk(a[2], a[3]); w.z = cvtpk(b[0], b[1]); w.w = cvtpk(b[2], b[3]); return w; }

template <int MODE, bool SSQ> struct EpiScaleBf16 {
    bf16_t* O; int ldc; RowScale rs; float* ssq;
    __device__ __forceinline__ void operator()(const f32x4 (&acc)[2][2][4][2], const Unit& u, int wr, int wc, int fr, int fq) const {
        { const int l_ = lane_id_opq(); fr = l_ & 15; fq = l_ >> 4; }
        const int row0 = u.pm * BM + wr * 64 + fr, colb = u.pn * BM + wc * 32 + 8 * fq;
#pragma unroll
        for (int ai = 0; ai < 2; ++ai)
#pragma unroll
            for (int m = 0; m < 4; ++m) { const int row = row0 + ai * HALF + m * 16; const float r = rs.get(row, fq);
#pragma unroll
                for (int bj = 0; bj < 2; ++bj) { const int col = colb + bj * HALF; const f32x4 v0 = acc[ai][bj][m][0] * r, v1 = acc[ai][bj][m][1] * r;
                    bf16_t* p = (MODE == 0) ? O + (size_t)row * ldc + col : O + ((size_t)(col >> 4) * 512 + (row >> 4)) * 384 + (row & 15) * 16 + (col & 15);
                    *(u32x4*)p = pack8(v0, v1);
                    if (SSQ) { float s = ssq8(v0, v1); s += __shfl_xor(s, 16); s += __shfl_xor(s, 32); if (fq == 0) ssq[(size_t)row * 32 + (u.pn * 2 + bj) * 4 + wc] = s; } }
                asm volatile("" ::: "memory"); }
    }
};
template <bool GLU> struct EpiRes {
    float* xout; bf16_t* xb; float* ssq; bool wf32;
    __device__ __forceinline__ void operator()(const f32x4 (&acc)[2][2][4][2], const Unit& u, int wr, int wc, int fr, int fq) const {
        { const int l_ = lane_id_opq(); fr = l_ & 15; fq = l_ >> 4; }
        const int row0 = u.pm * BM + wr * 64 + fr;
#pragma unroll
        for (int ai = 0; ai < 2; ++ai)
#pragma unroll
            for (int m = 0; m < 4; ++m) { const int row = row0 + ai * HALF + m * 16;
#pragma unroll
                for (int bj = 0; bj < (GLU ? 1 : 2); ++bj) { f32x4 v0, v1; int col, slot;
                    if (GLU) { col = u.pn * HALF + wc * 32 + 8 * fq; slot = u.pn * 4 + wc;
#pragma unroll
                        for (int e = 0; e < 4; ++e) { v0[e] = acc[ai][0][m][0][e] * sigmoidf_(acc[ai][1][m][0][e]); v1[e] = acc[ai][0][m][1][e] * sigmoidf_(acc[ai][1][m][1][e]); }
                    } else { col = u.pn * BM + bj * HALF + wc * 32 + 8 * fq; slot = (u.pn * 2 + bj) * 4 + wc; v0 = acc[ai][bj][m][0]; v1 = acc[ai][bj][m][1]; }
                    const size_t p = (size_t)row * DM + col; const u32x4 xw = *(const u32x4*)(xb + p);
                    const f32x4 x0 = (f32x4){bflo(xw.x), bfhi(xw.x), bflo(xw.y), bfhi(xw.y)} + v0, x1 = (f32x4){bflo(xw.z), bfhi(xw.z), bflo(xw.w), bfhi(xw.w)} + v1;
                    if (wf32) { *(f32x4*)(xout + p) = x0; *(f32x4*)(xout + p + 4) = x1; }
                    *(u32x4*)(xb + p) = pack8(x0, x1);
                    float s = ssq8(x0, x1); s += __shfl_xor(s, 16); s += __shfl_xor(s, 32); if (fq == 0) ssq[(size_t)row * 32 + slot] = s; }
                asm volatile("" ::: "memory"); }
    }
};
struct EpiSwiGLU {
    bf16_t* O; RowScale rs;
    __device__ __forceinline__ void operator()(const f32x4 (&acc)[2][2][4][2], const Unit& u, int wr, int wc, int fr, int fq) const {
        { const int l_ = lane_id_opq(); fr = l_ & 15; fq = l_ >> 4; }
        const int row0 = u.pm * BM + wr * 64 + fr, col = u.pn * HALF + wc * 32 + 8 * fq;
#pragma unroll
        for (int ai = 0; ai < 2; ++ai)
#pragma unroll
            for (int m = 0; m < 4; ++m) { const int row = row0 + ai * HALF + m * 16; const float r = rs.get(row, fq); f32x4 v0, v1;
#pragma unroll
                for (int e = 0; e < 4; ++e) { const float g0 = acc[ai][0][m][0][e] * r, g1 = acc[ai][0][m][1][e] * r;
                    v0[e] = g0 * sigmoidf_(g0) * (acc[ai][1][m][0][e] * r); v1[e] = g1 * sigmoidf_(g1) * (acc[ai][1][m][1][e] * r); }
                *(u32x4*)(O + (size_t)row * FF + col) = pack8(v0, v1); asm volatile("" ::: "memory"); }
    }
};
struct EpiSsmP {
    float* W;
    __device__ __forceinline__ void operator()(const f32x4 (&acc)[2][2][4][2], const Unit& u, int wr, int wc, int fr, int fq) const {
        { const int l_ = lane_id_opq(); fr = l_ & 15; fq = l_ >> 4; }
        const int row0 = u.pm * BM + wr * 64 + fr;
#pragma unroll
        for (int ai = 0; ai < 2; ++ai)
#pragma unroll
            for (int m = 0; m < 4; ++m) { const int row = row0 + ai * HALF + m * 16; float* p = W + ((size_t)u.pg * 512 + row) * 128 + wc * 32 + 8 * fq;
                *(f32x4*)p = acc[ai][0][m][0]; *(f32x4*)(p + 4) = acc[ai][0][m][1]; }
    }
};
struct EpiSsmY {
    const bf16_t* Ag; const float* dskip; bf16_t* z;
    __device__ __forceinline__ void operator()(const f32x4 (&acc)[2][2][4][2], const Unit& u, int wr, int wc, int fr, int fq) const {
        { const int l_ = lane_id_opq(); fr = l_ & 15; fq = l_ >> 4; }
        const int row0 = u.pm * BM + wr * 64 + fr, k0 = (fq & 1) * 8;
#pragma unroll
        for (int ai = 0; ai < 2; ++ai)
#pragma unroll
            for (int m = 0; m < 4; ++m) { const int row = row0 + ai * HALF + m * 16;
#pragma unroll
                for (int bj = 0; bj < 2; ++bj) { const int col = bj * HALF + wc * 32 + 8 * fq, t = col >> 4;
                    const u32x4 uw = *(const u32x4*)(Ag + ((size_t)u.pg * 512 + row) * 384 + col);
                    const f32x4 d0 = *(const f32x4*)(dskip + u.pg * 16 + k0), d1 = *(const f32x4*)(dskip + u.pg * 16 + k0 + 4);
                    f32x4 y0 = acc[ai][bj][m][0], y1 = acc[ai][bj][m][1];
                    y0[0] += d0[0] * bflo(uw.x); y0[1] += d0[1] * bfhi(uw.x); y0[2] += d0[2] * bflo(uw.y); y0[3] += d0[3] * bfhi(uw.y);
                    y1[0] += d1[0] * bflo(uw.z); y1[1] += d1[1] * bfhi(uw.z); y1[2] += d1[2] * bflo(uw.w); y1[3] += d1[3] * bfhi(uw.w);
#pragma unroll
                    for (int e = 0; e < 4; ++e) { y0[e] = gelu_tanh(y0[e]); y1[e] = gelu_tanh(y1[e]); }
                    *(u32x4*)(z + ((size_t)row * 16 + t) * DM + u.pg * 16 + k0) = pack8(y0, y1); asm volatile("" ::: "memory"); } }
    }
};
struct EpiHead {
    bf16_t* O; RowScale rs; const float* gn; const float* gr; const float* rc; const float* rsn; float osc;
    __device__ __forceinline__ void operator()(const f32x4 (&acc)[2][2][4][2], const Unit& u, int wr, int wc, int fr, int fq) const {
        { const int l_ = lane_id_opq(); fr = l_ & 15; fq = l_ >> 4; }
        const int row0 = u.pm * BM + wr * 64 + fr;
        if (u.pn < 4) { const int h = 4 * u.pn + wc;
#pragma unroll
            for (int ai = 0; ai < 2; ++ai)
#pragma unroll
                for (int m = 0; m < 4; ++m) { const int row = row0 + ai * HALF + m * 16; const float r = rs.get(row, fq);
                    const f32x4 a0 = acc[ai][0][m][0] * r, a1 = acc[ai][0][m][1] * r, b0 = acc[ai][1][m][0] * r, b1 = acc[ai][1][m][1] * r;
                    float s = ssq8(a0, a1) + ssq8(b0, b1); s += __shfl_xor(s, 16); s += __shfl_xor(s, 32);
                    const float rh = rsqrtf(s * (1.0f / 64) + EPS) * osc;
                    bf16_t* p = O + (size_t)row * 1536 + h * 96 + 8 * fq;
                    { const f32x4 g0 = *(const f32x4*)(gn + 8 * fq), g1 = *(const f32x4*)(gn + 8 * fq + 4); *(u32x4*)p = pack8(a0 * g0 * rh, a1 * g1 * rh); }
                    { const f32x4 g0 = *(const f32x4*)(gn + 32 + 8 * fq), g1 = *(const f32x4*)(gn + 32 + 8 * fq + 4); *(u32x4*)(p + 32) = pack8(b0 * g0 * rh, b1 * g1 * rh); }
                    asm volatile("" ::: "memory"); }
        } else { const int h = 8 * (u.pn - 4) + 2 * wc + (fq >> 1), i0 = (fq & 1) * 8;
#pragma unroll
            for (int ai = 0; ai < 2; ++ai)
#pragma unroll
                for (int m = 0; m < 4; ++m) { const int row = row0 + ai * HALF + m * 16; const float r = rs.get(row, fq);
                    f32x4 x1a = acc[ai][0][m][0] * r, x1b = acc[ai][0][m][1] * r, x2a = acc[ai][1][m][0] * r, x2b = acc[ai][1][m][1] * r;
                    float s = ssq8(x1a, x1b) + ssq8(x2a, x2b); s += __shfl_xor(s, 16);
                    const float rh = rsqrtf(s * (1.0f / 32) + EPS);
                    x1a = x1a * *(const f32x4*)(gr + i0) * rh; x1b = x1b * *(const f32x4*)(gr + i0 + 4) * rh; x2a = x2a * *(const f32x4*)(gr + 16 + i0) * rh; x2b = x2b * *(const f32x4*)(gr + 16 + i0 + 4) * rh;
                    const f32x4 ca = *(const f32x4*)(rc + (size_t)row * 16 + i0) * osc, cb = *(const f32x4*)(rc + (size_t)row * 16 + i0 + 4) * osc, sa = *(const f32x4*)(rsn + (size_t)row * 16 + i0) * osc, sb = *(const f32x4*)(rsn + (size_t)row * 16 + i0 + 4) * osc;
                    bf16_t* p = O + (size_t)row * 1536 + h * 96 + 64 + i0;
                    *(u32x4*)p = pack8(x1a * ca - x2a * sa, x1b * cb - x2b * sb);
                    *(u32x4*)(p + 16) = pack8(x1a * sa + x2a * ca, x1b * sb + x2b * cb);
                    asm volatile("" ::: "memory"); }
        }
    }
};
struct EpiVt {
    bf16_t* Vt; const float* slots2;
    __device__ __forceinline__ void operator()(const f32x4 (&acc)[2][2][4][2], const Unit& u, int wr, int wc, int fr, int fq) const {
        { const int l_ = lane_id_opq(); fr = l_ & 15; fq = l_ >> 4; }
        const int row0 = u.pm * BM + wr * 64 + fr;
#pragma unroll
        for (int bj = 0; bj < 2; ++bj) { const int tok0 = u.pn * BM + bj * HALF + wc * 32 + 8 * fq, b = tok0 >> 11, l = tok0 & 2047;
            float rt[8];
#pragma unroll
            for (int e = 0; e < 8; ++e) { const float* p = slots2 + (size_t)(tok0 + e) * 32 + 12; const f32x4 a = *(const f32x4*)p, b2 = *(const f32x4*)(p + 4);
                rt[e] = rsqrtf(((a[0] + a[1]) + (a[2] + a[3]) + (b2[0] + b2[1]) + (b2[2] + b2[3])) * (1.0f / 256) + EPS);
                if ((e & 1) == 1) asm volatile("" ::: "memory"); }
#pragma unroll
            for (int ai = 0; ai < 2; ++ai)
#pragma unroll
                for (int m = 0; m < 4; ++m) { const int row = row0 + ai * HALF + m * 16;
                    f32x4 v0 = acc[ai][bj][m][0], v1 = acc[ai][bj][m][1];
#pragma unroll
                    for (int e = 0; e < 4; ++e) { v0[e] *= rt[e]; v1[e] *= rt[4 + e]; }
                    *(u32x4*)(Vt + ((size_t)(b * 1024 + row)) * SEQ + l) = pack8(v0, v1); }
            asm volatile("" ::: "memory"); }
    }
};
}

struct Args { const float* in[N_IN]; float* out; unsigned char* ws; int ph_lo, ph_hi; };

__device__ __forceinline__ void sincos_rev(double rev, float& sn, float& cs) {
    const double fr = rev - rint(rev); const double q = rint(4.0 * fr); const double y = fr - 0.25 * q; const double x = 6.283185307179586 * y, x2 = x * x;
    const double s = x * (1.0 + x2 * (-1.0 / 6 + x2 * (1.0 / 120 + x2 * (-1.0 / 5040 + x2 * (1.0 / 362880 + x2 * (-1.0 / 39916800 + x2 * (1.0 / 6227020800.0)))))));
    const double c = 1.0 + x2 * (-0.5 + x2 * (1.0 / 24 + x2 * (-1.0 / 720 + x2 * (1.0 / 40320 + x2 * (-1.0 / 3628800 + x2 * (1.0 / 479001600.0 + x2 * (-1.0 / 87178291200.0)))))));
    const int qi = ((int)q) & 3;
    const double ss = (qi == 0) ? s : (qi == 1) ? c : (qi == 2) ? -s : -c;
    const double cc = (qi == 0) ? c : (qi == 1) ? -s : (qi == 2) ? -c : s;
    sn = (float)ss; cs = (float)cc;
}

__device__ __forceinline__ void tr_item(const float* W, int K, int N, const float* gain, bf16_t* dst, int ldk, int mode, int H, int drow0, LAS float* scr, int item, int lane) {
    const int nblk = N / 32, kb = item / nblk, nb = item % nblk, k0 = 64 * kb, n0 = 32 * nb;
#pragma unroll 8
    for (int i = 0; i < 32; ++i) { const int kk = 2 * i + (lane >> 5); float v = W[(size_t)(k0 + kk) * N + n0 + (lane & 31)]; if (gain) v *= gain[k0 + kk]; scr[kk * 33 + (lane & 31)] = v; }
    asm volatile("s_waitcnt lgkmcnt(0)" ::: "memory");
    int drow, extra16 = 0;
    if (mode == 0) drow = drow0 + n0;
    else if (mode == 1) { const int half = n0 / H, j = n0 % H; drow = drow0 + (j / 128) * 256 + half * 128 + (j % 128); }
    else if (mode == 2) { const int h = n0 / 128, part = (n0 % 128) / 32;
        drow = (part < 2) ? (h / 4) * 256 + part * 128 + (h % 4) * 32 : 1024 + h * 64 + (part - 2) * 32; }
    else { const int h = n0 / 96, part = (n0 % 96) / 32;
        if (part < 2) drow = (h / 4) * 256 + part * 128 + (h % 4) * 32; else { drow = 1024 + (h / 8) * 256 + ((h % 8) / 2) * 32 + (h % 2) * 16; extra16 = 112; } }
    const int c = lane & 7;
#pragma unroll
    for (int j = 0; j < 4; ++j) { const int n = (lane >> 3) + 8 * j; const LAS float* s = scr + (8 * c) * 33 + n;
        u32x4 o; o.x = cvtpk(s[0 * 33], s[1 * 33]); o.y = cvtpk(s[2 * 33], s[3 * 33]); o.z = cvtpk(s[4 * 33], s[5 * 33]); o.w = cvtpk(s[6 * 33], s[7 * 33]);
        *(u32x4*)(dst + (size_t)(drow + n + (n >= 16 ? extra16 : 0)) * ldk + k0 + 8 * c) = o; }
    asm volatile("s_waitcnt lgkmcnt(0)" ::: "memory");
}

__device__ __forceinline__ void ssm_precompute(const Args& a, LAS unsigned char* lds, int job, int tid_in) {
    const int tid = opq_v(tid_in), i = job >> 6, g = job & 63, ig = i * 64 + g;
    LAS float* apr = (LAS float*)lds;
    LAS float* api = apr + 17 * 64;
    LAS float* bbr = api + 17 * 64;
    LAS float* bbi = bbr + 1024;
    LAS float* ccr = bbi + 1024;
    LAS float* cci = ccr + 1024;
    LAS float* kern = cci + 1024;
    const float* lam_re = a.in[I_LRE] + (size_t)ig * 64; const float* lam_im = a.in[I_LIM] + (size_t)ig * 64;
    const double step = exp((double)a.in[I_LSTEP][ig]);
    __syncthreads();
    for (int idx = tid; idx < 17 * 64; idx += 512) { const int d = idx >> 6, n = idx & 63;
        const double lr = (double)lam_re[n], li = (double)lam_im[n];
        const double mag = exp(lr * step * d); float sn, cs; sincos_rev(li * step * d * 0.15915494309189535, sn, cs);
        apr[idx] = (float)(mag * cs); api[idx] = (float)(mag * sn); }
    for (int idx = tid; idx < 1024; idx += 512) { ccr[idx] = a.in[I_CRE][(size_t)ig * 1024 + idx]; cci[idx] = a.in[I_CIM][(size_t)ig * 1024 + idx]; }
    __syncthreads();
    for (int idx = tid; idx < 1024; idx += 512) { const int n = idx >> 4;
        const float lr = lam_re[n], li = lam_im[n], are = apr[64 + n], aim = api[64 + n], den = lr * lr + li * li;
        const float fre = ((are - 1.0f) * lr + aim * li) / den, fim = (aim * lr - (are - 1.0f) * li) / den;
        const float br = a.in[I_BRE][(size_t)ig * 1024 + idx], bi = a.in[I_BIM][(size_t)ig * 1024 + idx];
        bbr[idx] = fre * br - fim * bi; bbi[idx] = fre * bi + fim * br; }
    __syncthreads();
    for (int idx = tid; idx < 4096; idx += 512) { const int d = idx >> 8, k = (idx >> 4) & 15, kp = idx & 15; float s = 0.f;
        for (int n = 0; n < 64; ++n) { const float pr = apr[d * 64 + n], pi = api[d * 64 + n], br = bbr[n * 16 + kp], bi = bbi[n * 16 + kp];
            const float tr = pr * br - pi * bi, ti = pr * bi + pi * br; s += ccr[k * 64 + n] * tr - cci[k * 64 + n] * ti; }
        kern[idx] = s; }
    __syncthreads();
    bf16_t* bty = (bf16_t*)(a.ws + WS_BTY) + (size_t)ig * 256 * 384;
    for (int idx = tid; idx < 256 * 384; idx += 512) { const int row = idx / 384, col = idx % 384, t = row >> 4, k = row & 15; float v;
        if (col < 256) { const int j = col >> 4, kp = col & 15; v = (j <= t) ? kern[(t - j) * 256 + k * 16 + kp] : 0.f; }
        else if (col < 320) { const int n = col - 256; v = ccr[k * 64 + n] * apr[(t + 1) * 64 + n] - cci[k * 64 + n] * api[(t + 1) * 64 + n]; }
        else { const int n = col - 320; v = -(ccr[k * 64 + n] * api[(t + 1) * 64 + n] + cci[k * 64 + n] * apr[(t + 1) * 64 + n]); }
        bty[idx] = (bf16_t)(cvtpk(v, 0.f) & 0xffffu); }
    bf16_t* btp = (bf16_t*)(a.ws + WS_BTP) + (size_t)ig * 256 * 256;
    for (int idx = tid; idx < 256 * 256; idx += 512) { const int row = idx >> 8, col = idx & 255, j = col >> 4, kp = col & 15; float v = 0.f;
        if (row < 128) { const int n = row & 63; const float pr = apr[(15 - j) * 64 + n], pi = api[(15 - j) * 64 + n], br = bbr[n * 16 + kp], bi = bbi[n * 16 + kp];
            v = (row < 64) ? (pr * br - pi * bi) : (pr * bi + pi * br); }
        btp[idx] = (bf16_t)(cvtpk(v, 0.f) & 0xffffu); }
    float* ac = (float*)(a.ws + WS_AC) + (size_t)ig * 128;
    if (tid < 64) { ac[tid] = apr[16 * 64 + tid]; ac[64 + tid] = api[16 * 64 + tid]; }
    __syncthreads();
}

__device__ __forceinline__ void phase_setup(const Args& a, LAS unsigned char* lds, int tid_in) {
    const int tid = opq_v(tid_in), lane = tid & 63, wave = tid >> 6, G = opq_s(gridDim.x), bx = opq_s(blockIdx.x);
    for (int job = bx; job < 128; job += G) ssm_precompute(a, lds, job, tid_in);
    __syncthreads();
    LAS float* scr = (LAS float*)(lds + wave * 8448);
    const int gw = bx * 8 + wave, NGW = G * 8;
    unsigned char* ws = a.ws;
    constexpr int I_GU = 16 * 176, I_DN = 44 * 32, I_IN = 16 * 32, I_GL = 16 * 64, I_QA = 16 * 12, I_KVA = 16 * 9, I_QB = 6 * 48, I_KVB = 4 * 64, I_O = 16 * 32;
    constexpr int NITEMS = 4 * I_GU + 4 * I_DN + 2 * I_IN + 2 * I_GL + 2 * I_QA + I_KVA + 2 * I_QB + I_KVB + 2 * I_O;
    for (int it = gw; it < NITEMS; it += NGW) {
        int r = it;
        if (r < 4 * I_GU) { const int l = r / I_GU; tr_item(a.in[I_WGU] + (size_t)l * DM * 2 * FF, DM, 2 * FF, a.in[I_FFNN] + l * DM, (bf16_t*)(ws + WS_WGU) + (size_t)l * 2 * FF * DM, DM, 1, FF, 0, scr, r % I_GU, lane); continue; } r -= 4 * I_GU;
        if (r < 4 * I_DN) { const int l = r / I_DN; tr_item(a.in[I_WDN] + (size_t)l * FF * DM, FF, DM, nullptr, (bf16_t*)(ws + WS_WDN) + (size_t)l * DM * FF, FF, 0, 1, 0, scr, r % I_DN, lane); continue; } r -= 4 * I_DN;
        if (r < 2 * I_IN) { const int l = r / I_IN; tr_item(a.in[I_SWIN] + (size_t)l * DM * DM, DM, DM, a.in[I_MIXN] + l * DM, (bf16_t*)(ws + WS_WIN) + (size_t)l * DM * DM, DM, 0, 1, 0, scr, r % I_IN, lane); continue; } r -= 2 * I_IN;
        if (r < 2 * I_GL) { const int l = r / I_GL; tr_item(a.in[I_SGLU] + (size_t)l * DM * 2 * DM, DM, 2 * DM, nullptr, (bf16_t*)(ws + WS_WGLU) + (size_t)l * 2 * DM * DM, DM, 1, DM, 0, scr, r % I_GL, lane); continue; } r -= 2 * I_GL;
        if (r < I_QA) { tr_item(a.in[I_WQA], DM, 384, a.in[I_MIXN] + 2 * DM, (bf16_t*)(ws + WS_WQKVA), DM, 0, 1, 0, scr, r, lane); continue; } r -= I_QA;
        if (r < I_QA) { tr_item(a.in[I_WQA] + (size_t)DM * 384, DM, 384, a.in[I_MIXN] + 3 * DM, (bf16_t*)(ws + WS_WQA3), DM, 0, 1, 0, scr, r, lane); continue; } r -= I_QA;
        if (r < I_KVA) { tr_item(a.in[I_WKVA], DM, 288, a.in[I_KVINN], (bf16_t*)(ws + WS_WQKVA), DM, 0, 1, 384, scr, r, lane); continue; } r -= I_KVA;
        if (r < 2 * I_QB) { const int l = r / I_QB; tr_item(a.in[I_WQB] + (size_t)l * 384 * 1536, 384, 1536, a.in[I_QAN] + l * 384, (bf16_t*)(ws + WS_WQB) + (size_t)l * 1536 * 384, 384, 3, 1, 0, scr, r % I_QB, lane); continue; } r -= 2 * I_QB;
        if (r < I_KVB) { tr_item(a.in[I_WKVB], 256, 2048, a.in[I_KVAN], (bf16_t*)(ws + WS_WKVB), 256, 2, 1, 0, scr, r, lane); continue; } r -= I_KVB;
        { const int l = r / I_O; tr_item(a.in[I_WO] + (size_t)l * DM * DM, DM, DM, nullptr, (bf16_t*)(ws + WS_WO) + (size_t)l * DM * DM, DM, 0, 1, 0, scr, r % I_O, lane); }
    }
    { const int gt = bx * 512 + tid, NT_ = G * 512;
      u32x4* p0 = (u32x4*)((bf16_t*)(ws + WS_WQKVA) + (size_t)672 * DM); for (int i = gt; i < 96 * DM / 8; i += NT_) p0[i] = (u32x4){0u, 0u, 0u, 0u};
      u32x4* p1 = (u32x4*)((bf16_t*)(ws + WS_WQA3) + (size_t)384 * DM); for (int i = gt; i < 128 * DM / 8; i += NT_) p1[i] = (u32x4){0u, 0u, 0u, 0u};
      float* rc = (float*)(ws + WS_ROPE); float* rsn = rc + (size_t)T * 16; const int* pos = (const int*)a.in[I_POS];
      for (int i = gt; i < T * 16; i += NT_) { const int tok = i >> 4, f = i & 15; double inv = 1.0; for (int q = 0; q < f; ++q) inv *= 0.5623413251903491;
          float sn, cs; sincos_rev((double)pos[tok] * inv * 0.15915494309189535, sn, cs); rc[i] = cs; rsn[i] = sn; } }
    { const float* x = a.in[I_X]; bf16_t* xb = (bf16_t*)(ws + WS_XB); float* slots = (float*)(ws + WS_SLOT);
      for (int row = gw; row < T; row += NGW) { const f32x4* xr = (const f32x4*)(x + (size_t)row * DM) + lane; float s = 0.f;
#pragma unroll
          for (int j = 0; j < 4; ++j) { const f32x4 v = xr[64 * j]; s += (v[0] * v[0] + v[1] * v[1]) + (v[2] * v[2] + v[3] * v[3]);
              u32x2 w; w.x = cvtpk(v[0], v[1]); w.y = cvtpk(v[2], v[3]); *((u32x2*)(xb + (size_t)row * DM) + lane + 64 * j) = w; }
          s += __shfl_xor(s, 1); if ((lane & 1) == 0) slots[(size_t)row * 32 + (lane >> 1)] = s; } }
}

__device__ __forceinline__ void phase_scan(const Args& a, int layer, int tid_in) {
    const int bx_ = opq_s(blockIdx.x), gx = bx_ & 7;
    const float* W = (const float*)(a.ws + loff_(gx, L_WST)); bf16_t* Ag = (bf16_t*)(a.ws + loff_(gx, L_AG)); const float* ac = (const float*)(a.ws + WS_AC) + (size_t)layer * 64 * 128;
    for (int gt = (bx_ >> 3) * 512 + opq_v(tid_in); gt < 4 * 64 * 64; gt += 32 * 512) {
        const int n = gt & 63, g = (gt >> 6) & 63, b = gt >> 12;
        const float ar = ac[g * 128 + n], ai = ac[g * 128 + 64 + n]; float sr = 0.f, si = 0.f;
        const size_t row0 = (size_t)g * 512 + (size_t)b * 128;
        const float* w = W + row0 * 128 + n; bf16_t* o = Ag + row0 * 384 + 256 + n;
#pragma unroll 8
        for (int m = 0; m < 128; ++m) { const float wr_ = w[(size_t)m * 128], wi_ = w[(size_t)m * 128 + 64];
            o[(size_t)m * 384] = (bf16_t)(cvtpk(sr, 0.f) & 0xffffu); o[(size_t)m * 384 + 64] = (bf16_t)(cvtpk(si, 0.f) & 0xffffu);
            const float nr = ar * sr - ai * si + wr_, ni = ar * si + ai * sr + wi_; sr = nr; si = ni; }
    }
}

__device__ __forceinline__ void phase_krope(const Args& a, int tid_in) {
    unsigned char* ws = a.ws;
    const int bx_ = opq_s(blockIdx.x), gx = bx_ & 7;
    const bf16_t* qkva = (const bf16_t*)(ws + voff(gx, L_QKVA, 1536)); const float* slots2 = (const float*)(ws + WS_SLOT2);
    bf16_t* Kf = (bf16_t*)(ws + voff(gx, L_KF, 3072)); const float* rc = (const float*)(ws + WS_ROPE); const float* rsn = rc + (size_t)T * 16;
    const float* gkr = a.in[I_KROPEN];
    for (int gt = (bx_ >> 3) * 512 + opq_v(tid_in); gt < (int)GTOK * 4; gt += 32 * 512) { const int tok = gx * (int)GTOK + (gt >> 2), qd = gt & 3;
        const u32x2 w1 = *(const u32x2*)(qkva + (size_t)tok * 768 + 640 + 4 * qd), w2 = *(const u32x2*)(qkva + (size_t)tok * 768 + 656 + 4 * qd);
        const float r = rsqrtf(slots2[(size_t)tok * 32 + 20] * (1.0f / 32) + EPS);
        const float x1[4] = {bflo(w1.x), bfhi(w1.x), bflo(w1.y), bfhi(w1.y)}, x2[4] = {bflo(w2.x), bfhi(w2.x), bflo(w2.y), bfhi(w2.y)}; float o1[4], o2[4];
#pragma unroll
        for (int e = 0; e < 4; ++e) { const int i = 4 * qd + e; const float a1 = x1[e] * r * gkr[i], a2 = x2[e] * r * gkr[16 + i], c = rc[(size_t)tok * 16 + i], s = rsn[(size_t)tok * 16 + i];
            o1[e] = a1 * c - a2 * s; o2[e] = a1 * s + a2 * c; }
        u32x2 p1, p2; p1.x = cvtpk(o1[0], o1[1]); p1.y = cvtpk(o1[2], o1[3]); p2.x = cvtpk(o2[0], o2[1]); p2.y = cvtpk(o2[2], o2[3]);
#pragma unroll
        for (int h = 0; h < NH; ++h) { *(u32x2*)(Kf + (size_t)tok * 1536 + h * 96 + 64 + 4 * qd) = p1; *(u32x2*)(Kf + (size_t)tok * 1536 + h * 96 + 80 + 4 * qd) = p2; } }
}

__device__ __forceinline__ int crow(int r, int hi) { return (r & 3) + 8 * (r >> 2) + 4 * hi; }
constexpr int AT_KROW = 208, AT_KBUF = 64 * AT_KROW, AT_VROW = 136, AT_VBUF = 64 * AT_VROW, AT_VOFF = 2 * AT_KBUF;
template <bool FIXED>
__device__ __forceinline__ void attn_unit(LAS unsigned char* lds, const bf16_t* Q, const bf16_t* Kf, const bf16_t* Vt, bf16_t* O, int b, int h, int qb, int tid_in, float negB) {
    const int tid = opq_v(tid_in), lane = tid & 63, r32 = lane & 31, hi = lane >> 5; const int wid = __builtin_amdgcn_readfirstlane(tid >> 6);
    const int q0 = qb * 256; const size_t rowbase = (size_t)b * SEQ;
    const int qabs = q0 + wid * 32 + r32;
    bf16x8 qf[6];
    { const bf16_t* qp = Q + (rowbase + qabs) * 1536 + h * 96 + hi * 8;
#pragma unroll
      for (int s = 0; s < 6; ++s) qf[s] = *(const bf16x8*)(qp + 16 * s); }
    const int NT_ = (q0 + 256) / 64;
    const int kr0 = tid / 12, kp0 = tid % 12, kr1 = (512 + tid) / 12, kp1 = (512 + tid) % 12; const bool k2 = tid < 256;
    const bf16_t* kg0 = Kf + (rowbase + kr0) * 1536 + h * 96 + kp0 * 8;
    const bf16_t* kg1 = Kf + (rowbase + kr1) * 1536 + h * 96 + kp1 * 8;
    const int kl0 = kr0 * AT_KROW + kp0 * 16, kl1 = kr1 * AT_KROW + kp1 * 16;
    const int vd = tid >> 3, vp = tid & 7;
    const bf16_t* vg = Vt + ((size_t)(b * NH + h) * 64 + vd) * SEQ + vp * 8;
    const int vl = AT_VOFF + vd * AT_VROW + vp * 16;
    u32x4 kreg0, kreg1 = (u32x4){0u, 0u, 0u, 0u}, vreg;
    kreg0 = *(const u32x4*)kg0; if (k2) kreg1 = *(const u32x4*)kg1; vreg = *(const u32x4*)vg;
    *(LAS u32x4*)(lds + kl0) = kreg0; if (k2) *(LAS u32x4*)(lds + kl1) = kreg1;
    *(LAS u32x2*)(lds + vl) = (u32x2){vreg.x, vreg.y}; *(LAS u32x2*)(lds + vl + 8) = (u32x2){vreg.z, vreg.w};
    __syncthreads();
    float m_run = -1e30f, l_run = 0.f; f32x16 o0, o1, cinit;
#pragma unroll
    for (int r = 0; r < 16; ++r) { o0[r] = 0.f; o1[r] = 0.f; cinit[r] = FIXED ? negB : 0.f; }
    for (int t = 0; t < NT_; ++t) {
        const bool pre = (t + 1 < NT_);
        if (pre) { kreg0 = *(const u32x4*)(kg0 + (size_t)(t + 1) * 64 * 1536); if (k2) kreg1 = *(const u32x4*)(kg1 + (size_t)(t + 1) * 64 * 1536); vreg = *(const u32x4*)(vg + (t + 1) * 64); }
        const int kv0 = t * 64;
        if (kv0 <= q0 + wid * 32 + 31) {
            const LAS unsigned char* kb = lds + (t & 1) * AT_KBUF + r32 * AT_KROW + hi * 16;
            const LAS unsigned char* vb = lds + AT_VOFF + (t & 1) * AT_VBUF + r32 * AT_VROW + hi * 8;
            f32x16 s0, s1;
            { bf16x8 kf[12];
#pragma unroll
              for (int s = 0; s < 6; ++s) { kf[2 * s] = *(const LAS bf16x8*)(kb + s * 32); kf[2 * s + 1] = *(const LAS bf16x8*)(kb + 32 * AT_KROW + s * 32); }
              asm volatile("s_waitcnt lgkmcnt(0)" ::: "memory"); __builtin_amdgcn_sched_barrier(0);
#pragma unroll
              for (int s = 0; s < 6; ++s) { s0 = __builtin_amdgcn_mfma_f32_32x32x16_bf16(kf[2 * s], qf[s], s == 0 ? cinit : s0, 0, 0, 0); s1 = __builtin_amdgcn_mfma_f32_32x32x16_bf16(kf[2 * s + 1], qf[s], s == 0 ? cinit : s1, 0, 0, 0); } }
            __builtin_amdgcn_sched_barrier(0);
            u32x2 vf[16];
#pragma unroll
            for (int s = 0; s < 4; ++s) { vf[4 * s] = *(const LAS u32x2*)(vb + s * 32); vf[4 * s + 1] = *(const LAS u32x2*)(vb + s * 32 + 16);
                vf[4 * s + 2] = *(const LAS u32x2*)(vb + 32 * AT_VROW + s * 32); vf[4 * s + 3] = *(const LAS u32x2*)(vb + 32 * AT_VROW + s * 32 + 16); }
            if (kv0 + 63 > q0 + wid * 32) {
#pragma unroll
                for (int r = 0; r < 16; ++r) { const int kv = kv0 + crow(r, hi); if (kv > qabs) s0[r] = -1e30f; if (kv + 32 > qabs) s1[r] = -1e30f; }
            }
            if (FIXED) {
                float ps = 0.f;
#pragma unroll
                for (int r = 0; r < 16; ++r) { s0[r] = __builtin_amdgcn_exp2f(s0[r]); s1[r] = __builtin_amdgcn_exp2f(s1[r]); ps += s0[r] + s1[r]; }
                l_run += ps;
            } else {
                float mx = fmaxf(s0[0], s1[0]);
#pragma unroll
                for (int r = 1; r < 16; ++r) mx = fmaxf(mx, fmaxf(s0[r], s1[r]));
                mx = fmaxf(mx, __shfl_xor(mx, 32));
                const float m_new = fmaxf(m_run, mx), alpha = __builtin_amdgcn_exp2f(m_run - m_new); m_run = m_new;
                float ps = 0.f;
#pragma unroll
                for (int r = 0; r < 16; ++r) { s0[r] = __builtin_amdgcn_exp2f(s0[r] - m_new); s1[r] = __builtin_amdgcn_exp2f(s1[r] - m_new); ps += s0[r] + s1[r]; }
                l_run = l_run * alpha + ps;
#pragma unroll
                for (int r = 0; r < 16; ++r) { o0[r] *= alpha; o1[r] *= alpha; }
            }
            bf16x8 pk[4];
#pragma unroll
            for (int s = 0; s < 4; ++s) { u32x4 w;
#pragma unroll
                for (int e = 0; e < 4; ++e) { const int r = 8 * (s & 1) + 2 * e; w[e] = (s < 2) ? cvtpk(s0[r], s0[r + 1]) : cvtpk(s1[r], s1[r + 1]); }
                pk[s] = __builtin_bit_cast(bf16x8, w); }
            asm volatile("s_waitcnt lgkmcnt(0)" ::: "memory"); __builtin_amdgcn_sched_barrier(0);
#pragma unroll
            for (int s = 0; s < 4; ++s) {
                { const u32x4 w = (u32x4){vf[4 * s].x, vf[4 * s].y, vf[4 * s + 1].x, vf[4 * s + 1].y}; o0 = __builtin_amdgcn_mfma_f32_32x32x16_bf16(__builtin_bit_cast(bf16x8, w), pk[s], o0, 0, 0, 0); }
                { const u32x4 w = (u32x4){vf[4 * s + 2].x, vf[4 * s + 2].y, vf[4 * s + 3].x, vf[4 * s + 3].y}; o1 = __builtin_amdgcn_mfma_f32_32x32x16_bf16(__builtin_bit_cast(bf16x8, w), pk[s], o1, 0, 0, 0); }
            }
        }
        if (pre) { const int bo = ((t + 1) & 1); *(LAS u32x4*)(lds + bo * AT_KBUF + kl0) = kreg0; if (k2) *(LAS u32x4*)(lds + bo * AT_KBUF + kl1) = kreg1;
            *(LAS u32x2*)(lds + bo * AT_VBUF + vl) = (u32x2){vreg.x, vreg.y}; *(LAS u32x2*)(lds + bo * AT_VBUF + vl + 8) = (u32x2){vreg.z, vreg.w}; }
        __syncthreads();
    }
    const float lt = l_run + __shfl_xor(l_run, 32), inv = 1.0f / lt;
    bf16_t* op = O + (rowbase + qabs) * DM + h * 64 + 4 * hi;
#pragma unroll
    for (int g = 0; g < 4; ++g) { u32x2 w; w.x = cvtpk(o0[4 * g] * inv, o0[4 * g + 1] * inv); w.y = cvtpk(o0[4 * g + 2] * inv, o0[4 * g + 3] * inv); *(u32x2*)(op + 8 * g) = w;
        u32x2 w2; w2.x = cvtpk(o1[4 * g] * inv, o1[4 * g + 1] * inv); w2.y = cvtpk(o1[4 * g + 2] * inv, o1[4 * g + 3] * inv); *(u32x2*)(op + 32 + 8 * g) = w2; }
}
__device__ __forceinline__ float wave_max(float v) {
#pragma unroll
    for (int o = 1; o < 64; o <<= 1) v = fmaxf(v, __shfl_xor(v, o));
    return v;
}
__device__ __forceinline__ void phase_attn(const Args& a, LAS unsigned char* lds, int tid_in, int j) {
    const int gx_ = opq_s(blockIdx.x) & 7;
    const bf16_t* Q = (const bf16_t*)(a.ws + voff(gx_, L_QRAW, 3072)); const bf16_t* Kf = (const bf16_t*)(a.ws + voff(gx_, L_KF, 3072)); const bf16_t* Vt = (const bf16_t*)(a.ws + voff(gx_, L_VT, 2048)); bf16_t* O = (bf16_t*)(a.ws + voff(gx_, L_O, 2048));
    float B;
    { const int lane = opq_v(tid_in) & 63;
      const float gqn = wave_max(fabsf(a.in[I_QNOPEN][j * 64 + lane])), gkn = wave_max(fabsf(a.in[I_KNOPEN][lane]));
      const float gqr = wave_max(fabsf(a.in[I_QROPEN][j * 32 + (lane & 31)])), gkr = wave_max(fabsf(a.in[I_KROPEN][lane & 31]));
      B = sqrtf(64.f * gqn * gqn + 32.f * gqr * gqr) * sqrtf(64.f * gkn * gkn + 32.f * gkr * gkr) * QSCALE * 1.02f; }
    const bool fixed = (B <= 40.0f);
    const int bx = opq_s(blockIdx.x); const int vcu = (bx & 7) * 32 + (bx >> 3);
    for (int p = vcu * 8; p < vcu * 8 + 8; ++p) {
        const int bh = p >> 2, s = p & 3;
        if (fixed) { attn_unit<true>(lds, Q, Kf, Vt, O, bh / NH, bh % NH, 7 - s, tid_in, -B); attn_unit<true>(lds, Q, Kf, Vt, O, bh / NH, bh % NH, s, tid_in, -B); }
        else { attn_unit<false>(lds, Q, Kf, Vt, O, bh / NH, bh % NH, 7 - s, tid_in, 0.f); attn_unit<false>(lds, Q, Kf, Vt, O, bh / NH, bh % NH, s, tid_in, 0.f); }
    }
}

#define XB_TMO      128
#define XB_XCNT(j)  (256  + 64 * (j))
#define XB_XSUB(j)  (1280 + 64 * (j))
#define XB_XGEN(j)  (2304 + 64 * (j))
#define XB_TOP      3328
#define XB_TOPGEN   3392
#define XCD_BAR_WORDS 3456
#define XB_SPIN_CAP (1u << 18)

__device__ __forceinline__ unsigned xb_ld(unsigned* p)              { return __hip_atomic_load(p, __ATOMIC_RELAXED, __HIP_MEMORY_SCOPE_AGENT); }
__device__ __forceinline__ unsigned xb_add(unsigned* p, unsigned v) { return __hip_atomic_fetch_add(p, v, __ATOMIC_RELAXED, __HIP_MEMORY_SCOPE_AGENT); }
__device__ __forceinline__ unsigned xb_xcc_id() { return (unsigned)__builtin_amdgcn_s_getreg((3 << 11) | 20) & 0xFu; }
#define XB_SPIN(cond, bar) do { unsigned _sp = 0; while (cond) { __builtin_amdgcn_s_sleep(1); \
    if ((++_sp & 255u) == 0u) { if (xb_ld(&(bar)[XB_TMO])) break; if (_sp > XB_SPIN_CAP) { atomicAdd(&(bar)[XB_TMO], 1u); break; } } } } while (0)

#ifndef GB_SKIP_WB
#define GB_SKIP_WB 1
#endif
struct XcdBarrier {
    unsigned* bar; unsigned x; unsigned gsz;
    volatile LAS unsigned* st;
};

__device__ __forceinline__ XcdBarrier xcd_barrier_post(unsigned* bar, volatile LAS unsigned* st) {
    XcdBarrier b; b.bar = bar; b.x = xb_xcc_id(); b.st = st;
    if (threadIdx.x == 0) (void)xb_add(&bar[XB_XCNT(b.x)], 1u);
    return b;
}
__device__ __forceinline__ void xcd_barrier_complete(unsigned* bar, unsigned x, unsigned& nloc, unsigned& nx, unsigned G) {
    unsigned sum, cnt, mine, sp = 0u;
    for (;;) {
        sum = 0u; cnt = 0u; mine = 0u;
#pragma unroll
        for (unsigned j = 0; j < 16; ++j) { const unsigned c = xb_ld(&bar[XB_XCNT(j)]); sum += c; cnt += (c > 0u) ? 1u : 0u; mine = (j == x) ? c : mine; }
        if (sum == G) break;
        __builtin_amdgcn_s_sleep(1);
        if ((++sp & 255u) == 0u) { if (xb_ld(&bar[XB_TMO])) break; if (sp > XB_SPIN_CAP) { atomicAdd(&bar[XB_TMO], 1u); break; } }
    }
    nloc = mine > 0u ? mine : 1u; nx = cnt > 0u ? cnt : 1u;
}

__device__ __forceinline__ void xcd_barrier(const XcdBarrier& b, int tid_in) {
    asm volatile("s_waitcnt vmcnt(0)" ::: "memory");
    __syncthreads();
    if (tid_in == 0) {
        unsigned* bar = b.bar; asm volatile("" : "+s"(bar));
        __builtin_amdgcn_s_waitcnt(0);
        unsigned nloc = b.st[0], nx = b.st[1];
        if (nloc == 0u) { xcd_barrier_complete(bar, b.x, nloc, nx, b.gsz); b.st[0] = nloc; b.st[1] = nx; }
        const unsigned old = xb_add(&bar[XB_XSUB(b.x)], 1u);
        const unsigned gen = old / nloc;
        if (old + 1u == (gen + 1u) * nloc) {
            if (GB_SKIP_WB == 0 || nx > 1u) {
            __builtin_amdgcn_fence(__ATOMIC_RELEASE, "agent");
            asm volatile("s_waitcnt vmcnt(0)" ::: "memory"); }
            const unsigned og = xb_add(&bar[XB_TOP], 1u);
            const unsigned tg = og / nx;
            if (og + 1u == (tg + 1u) * nx) xb_add(&bar[XB_TOPGEN], 1u);
            else XB_SPIN(xb_ld(&bar[XB_TOPGEN]) == tg, bar);
            __builtin_amdgcn_fence(__ATOMIC_ACQUIRE, "agent");
            xb_add(&bar[XB_XGEN(b.x)], 1u);
            asm volatile("s_waitcnt vmcnt(0)" ::: "memory");
        } else {
            XB_SPIN(xb_ld(&bar[XB_XGEN(b.x)]) == gen, bar);
            __builtin_amdgcn_fence(__ATOMIC_ACQUIRE, "agent");
            asm volatile("s_waitcnt vmcnt(0)" ::: "memory");
        }
    }
    __syncthreads();
}

#ifndef PHMASK
#define PHMASK 0xFFFFFFFFu
#endif
#define EN(k) (((PHMASK) >> (k)) & 1u)
#ifndef REPMASK
#define REPMASK 0u
#endif
#define REP(k) (((REPMASK) >> (k)) & 1u)
constexpr int LDS_BYTES = 131072 + 256;
#if defined(__HIP_DEVICE_COMPILE__)
typedef const __attribute__((address_space(4))) Args* kargs_t;
#else
typedef const Args* kargs_t;
#endif
__device__ __forceinline__ kargs_t args_ptr() {
    unsigned long long v = (unsigned long long)__builtin_amdgcn_kernarg_segment_ptr(); asm volatile("" : "+s"(v)); return (kargs_t)v;
}
__global__ void __launch_bounds__(512, 2) yoco_fwd(Args a0) {
    extern __shared__ __attribute__((aligned(16))) unsigned char lds_raw[];
    LAS unsigned char* lds = (LAS unsigned char*)lds_raw;
    cg::grid_group grid = cg::this_grid();
    const int G = gridDim.x, bx = blockIdx.x;
    const int s_wid = __builtin_amdgcn_readfirstlane((int)threadIdx.x >> 6);
#define TIDV ((s_wid << 6) | lane_id_opq())
    if (threadIdx.x < 64) ((LAS unsigned*)(lds + 131072))[threadIdx.x] = 0u;
    __syncthreads();
    XcdBarrier xbar = xcd_barrier_post((unsigned*)(a0.ws + WS_BAR + (size_t)(bx & 7) * WS_BAR_GRP), (volatile LAS unsigned*)(lds + 131072)); xbar.gsz = 32u;
#define GRID_SYNC() xcd_barrier(xbar, TIDV)
#define PHASE_BEGIN(k) { for (int rep_ = 0; rep_ <= (int)REP(k); ++rep_) { if (rep_) GRID_SYNC(); const Args a = *args_ptr(); unsigned char* ws = a.ws; const int gx = opq_s(bx) & 7; (void)gx; bf16_t* xb = (bf16_t*)(ws + WS_XB); float* slots = (float*)(ws + WS_SLOT); float* slots2 = (float*)(ws + WS_SLOT2); (void)xb; (void)slots; (void)slots2;
#define PHASE_END   } GRID_SYNC(); }
#define PHASE_END_LAST(cond) } if (cond) GRID_SYNC(); }
    using namespace pg8;
#ifdef EXTRA_SYNCS
    for (int i_ = 0; i_ < EXTRA_SYNCS; ++i_) GRID_SYNC();
#endif
    PHASE_BEGIN(0) phase_setup(a, lds, TIDV); } grid.sync(); }
#pragma unroll 1
    for (int layer = 0; layer < 4; ++layer) {
        if (layer < 2) {
            PHASE_BEGIN(1) { Gemm g{xb, (const bf16_t*)(ws + WS_WIN) + (size_t)layer * DM * DM, DM, DM, DM, 0, 0}; Sched S; S.init(T, DM, 1, opq_s(G), opq_s(bx));
                EpiScaleBf16<1, false> E{(bf16_t*)(ws + voff(gx, L_AG, 48)), 0, RowScale{slots, 0, 8, 1.0f / DM}, nullptr}; gemm_phase<EpiScaleBf16<1, false>, true>(lds, g, S, E, TIDV); } PHASE_END
            PHASE_BEGIN(2) { Gemm g{(const bf16_t*)(ws + loff_(gx, L_AG)), (const bf16_t*)(ws + WS_BTP) + (size_t)layer * 64 * 256 * 256, 256, 384, 256, 512L * 384, 256L * 256}; Sched S; S.init_local(1, opq_s(bx));
                EpiSsmP E{(float*)(ws + loff_(gx, L_WST))}; gemm_phase<EpiSsmP, true>(lds, g, S, E, TIDV); } PHASE_END
            PHASE_BEGIN(3) phase_scan(a, layer, TIDV); PHASE_END
            PHASE_BEGIN(4) { Gemm g{(const bf16_t*)(ws + loff_(gx, L_AG)), (const bf16_t*)(ws + WS_BTY) + (size_t)layer * 64 * 256 * 384, 384, 384, 384, 512L * 384, 256L * 384}; Sched S; S.init_local(1, opq_s(bx));
                EpiSsmY E{(const bf16_t*)(ws + loff_(gx, L_AG)), a.in[I_SD] + layer * DM, (bf16_t*)(ws + loff_(gx, L_Z))}; gemm_phase<EpiSsmY, true>(lds, g, S, E, TIDV); } PHASE_END
            PHASE_BEGIN(5) { Gemm g{(const bf16_t*)(ws + voff(gx, L_Z, 2048)), (const bf16_t*)(ws + WS_WGLU) + (size_t)layer * 2 * DM * DM, DM, DM, DM, 0, 0}; Sched S; S.init(T, 2 * DM, 1, opq_s(G), opq_s(bx));
                EpiRes<true> E{a.out, xb, slots, false}; gemm_phase<EpiRes<true>, true>(lds, g, S, E, TIDV); } PHASE_END
        } else {
            const int j = layer - 2;
            if (j == 0) {
                PHASE_BEGIN(6) { Gemm g{xb, (const bf16_t*)(ws + WS_WQKVA), DM, DM, DM, 0, 0}; Sched S; S.init(T, 768, 1, opq_s(G), opq_s(bx));
                    EpiScaleBf16<0, true> E{(bf16_t*)(ws + voff(gx, L_QKVA, 1536)), 768, RowScale{slots, 0, 8, 1.0f / DM}, slots2}; gemm_phase<EpiScaleBf16<0, true>, true>(lds, g, S, E, TIDV); } PHASE_END
                PHASE_BEGIN(7) { phase_krope(a, TIDV);
                    { Gemm g{(const bf16_t*)(ws + voff(gx, L_QKVA, 1536)) + 384, (const bf16_t*)(ws + WS_WKVB), 256, 768, 256, 0, 0}; Sched S; S.init(T, 1024, 1, opq_s(G), opq_s(bx));
                      EpiHead E{(bf16_t*)(ws + voff(gx, L_KF, 3072)), RowScale{slots2, 12, 2, 1.0f / 256}, a.in[I_KNOPEN], nullptr, nullptr, nullptr, 1.0f}; gemm_phase<EpiHead, true>(lds, g, S, E, TIDV); }
                    { Gemm g{(const bf16_t*)(ws + WS_WKVB) + (size_t)1024 * 256, (const bf16_t*)(ws + voff(gx, L_QKVA, 1536)) + 384, 256, 256, 768, 0, 0}; Sched S; S.init_local(2, opq_s(bx));
                      EpiVt E{(bf16_t*)(ws + voff(gx, L_VT, 2048)), slots2}; gemm_phase<EpiVt, true>(lds, g, S, E, TIDV); }
                    { Gemm g{(const bf16_t*)(ws + voff(gx, L_QKVA, 1536)), (const bf16_t*)(ws + WS_WQB), 384, 768, 384, 0, 0}; Sched S; S.init(T, 1536, 1, opq_s(G), opq_s(bx));
                      EpiHead E{(bf16_t*)(ws + voff(gx, L_QRAW, 3072)), RowScale{slots2, 0, 3, 1.0f / 384}, a.in[I_QNOPEN], a.in[I_QROPEN], (const float*)(ws + WS_ROPE), (const float*)(ws + WS_ROPE) + (size_t)T * 16, QSCALE}; gemm_phase<EpiHead, true>(lds, g, S, E, TIDV); } } PHASE_END
            } else {
                PHASE_BEGIN(10) { Gemm g{xb, (const bf16_t*)(ws + WS_WQA3), DM, DM, DM, 0, 0}; Sched S; S.init(T, 512, 1, opq_s(G), opq_s(bx));
                    EpiScaleBf16<0, true> E{(bf16_t*)(ws + voff(gx, L_QKVA, 1024)), 512, RowScale{slots, 0, 8, 1.0f / DM}, slots2}; gemm_phase<EpiScaleBf16<0, true>, true>(lds, g, S, E, TIDV); } PHASE_END
                PHASE_BEGIN(11) { Gemm g{(const bf16_t*)(ws + voff(gx, L_QKVA, 1024)), (const bf16_t*)(ws + WS_WQB) + (size_t)1536 * 384, 384, 512, 384, 0, 0}; Sched S; S.init(T, 1536, 1, opq_s(G), opq_s(bx));
                    EpiHead E{(bf16_t*)(ws + voff(gx, L_QRAW, 3072)), RowScale{slots2, 0, 3, 1.0f / 384}, a.in[I_QNOPEN] + 64, a.in[I_QROPEN] + 32, (const float*)(ws + WS_ROPE), (const float*)(ws + WS_ROPE) + (size_t)T * 16, QSCALE}; gemm_phase<EpiHead, true>(lds, g, S, E, TIDV); } PHASE_END
            }
            PHASE_BEGIN(13) phase_attn(a, lds, TIDV, j); PHASE_END
            PHASE_BEGIN(14) { Gemm g{(const bf16_t*)(ws + voff(gx, L_O, 2048)), (const bf16_t*)(ws + WS_WO) + (size_t)j * DM * DM, DM, DM, DM, 0, 0}; Sched S; S.init(T, DM, 1, opq_s(G), opq_s(bx));
                EpiRes<false> E{a.out, xb, slots, false}; gemm_phase<EpiRes<false>, true>(lds, g, S, E, TIDV); } PHASE_END
        }
        PHASE_BEGIN(15) { Gemm g{xb, (const bf16_t*)(ws + WS_WGU) + (size_t)layer * 2 * FF * DM, DM, DM, DM, 0, 0}; Sched S; S.init(T, 2 * FF, 1, opq_s(G), opq_s(bx));
            EpiSwiGLU E{(bf16_t*)(ws + voff(gx, L_FFA, 5632)), RowScale{slots, 0, 8, 1.0f / DM}}; gemm_phase<EpiSwiGLU, true>(lds, g, S, E, TIDV); } PHASE_END
        PHASE_BEGIN(16) { Gemm g{(const bf16_t*)(ws + voff(gx, L_FFA, 5632)), (const bf16_t*)(ws + WS_WDN) + (size_t)layer * DM * FF, FF, FF, FF, 0, 0}; Sched S; S.init(T, DM, 1, opq_s(G), opq_s(bx));
            EpiRes<false> E{a.out, xb, slots, layer == 3}; gemm_phase<EpiRes<false>, true>(lds, g, S, E, TIDV); } PHASE_END_LAST(layer < 3)
    }
}

extern "C" void kernel_launch(void* const* d_in, const int* in_sizes, int n_in, void* d_out, int out_size, void* d_ws, size_t ws_size, hipStream_t stream) {
    static int grid = 0;
    if (grid == 0) {
        if (n_in != N_IN || out_size != T * DM || ws_size < WS_END) { fprintf(stderr, "kernel_launch: unexpected shapes (n_in %d out %d ws %zu)\n", n_in, out_size, ws_size); grid = -1; return; }
        int dev = 0, cus = 0, per = 0;
        (void)hipGetDevice(&dev); (void)hipDeviceGetAttribute(&cus, hipDeviceAttributeMultiprocessorCount, dev);
        (void)hipFuncSetAttribute((const void*)yoco_fwd, hipFuncAttributeMaxDynamicSharedMemorySize, LDS_BYTES);
        (void)hipOccupancyMaxActiveBlocksPerMultiprocessor(&per, (const void*)yoco_fwd, 512, LDS_BYTES);
        if (per < 1) per = 1;
        grid = cus * per;
        if (grid != 256) { fprintf(stderr, "kernel_launch: this build needs a 256-workgroup grid (8 groups of 32), got %d; nothing launched\n", grid); grid = -1; return; }
        fprintf(stderr, "kernel_launch: grid %d (cus %d x %d)\n", grid, cus, per);
    }
    if (grid < 0) return;
    (void)hipMemsetAsync((unsigned char*)d_ws + WS_BAR, 0, WS_BAR_BYTES, stream);
    Args a{};
    for (int i = 0; i < N_IN; ++i) a.in[i] = (const float*)d_in[i];
    a.out = (float*)d_out; a.ws = (unsigned char*)d_ws; a.ph_lo = 0; a.ph_hi = 1000;
    void* args[] = {&a};
    hipError_t e = hipLaunchCooperativeKernel((const void*)yoco_fwd, dim3(grid), dim3(512), args, LDS_BYTES, stream);
    if (e != hipSuccess) fprintf(stderr, "kernel_launch: cooperative launch failed: %s (grid %d)\n", hipGetErrorString(e), grid);
}
```

```cpp
#include <hip/hip_runtime.h>
#include <hip/hip_cooperative_groups.h>
#include <cstdio>
#include <cstdint>
namespace cg = cooperative_groups;

#define LAS __attribute__((address_space(3)))
typedef unsigned short bf16_t;
typedef short bf16x8 __attribute__((ext_vector_type(8)));
typedef float f32x4 __attribute__((ext_vector_type(4)));
typedef float f32x16 __attribute__((ext_vector_type(16)));
typedef unsigned u32x4 __attribute__((ext_vector_type(4)));
typedef unsigned u32x2 __attribute__((ext_vector_type(2)));
typedef float f32x2_t __attribute__((ext_vector_type(2)));
typedef __bf16 bf16x2_t __attribute__((ext_vector_type(2)));

constexpr int T = 65536, DM = 1024, SEQ = 2048, NB = 32, FF = 2816, NH = 16;
constexpr float EPS = 1e-6f;
constexpr float QSCALE = 0.14724444f;

constexpr size_t MiB = 1u << 20;
constexpr size_t WS_WIN = 0, WS_WGLU = 4 * MiB, WS_WGU = 12 * MiB, WS_WDN = 56 * MiB, WS_WQKVA = 78 * MiB, WS_WQA3 = 80 * MiB,
                 WS_WQB = 81 * MiB, WS_WKVB = 84 * MiB, WS_WO = 85 * MiB, WS_BTY = 90 * MiB, WS_BTP = 114 * MiB, WS_AC = 130 * MiB,
                 WS_ROPE = 131 * MiB, WS_SLOT = 139 * MiB, WS_SLOT2 = 147 * MiB, WS_XB = 155 * MiB,
                 WS_KF = 283 * MiB, WS_VT = 475 * MiB, WS_R = 603 * MiB, WS_END = 1024 * MiB;
constexpr size_t WS_BAR = 130 * MiB + 512 * 1024, WS_BAR_GRP = 16384, WS_BAR_BYTES = 8 * WS_BAR_GRP;
constexpr size_t SLICE0 = 283 * MiB, SLICE = (741 * MiB) / 8, GTOK = 8192;
constexpr size_t L_KF = 0, L_KR = 16 * MiB, L_AG = 0, L_VT = 24 * MiB, L_WST = 24 * MiB, L_R = 40 * MiB, L_FFA = L_R, L_Z = L_R, L_QRAW = L_R, L_O = L_R + 24 * MiB + 512 * 1024, L_QKVA = L_R + 37 * MiB + 512 * 1024;
__host__ __device__ __forceinline__ size_t voff(int gx, size_t loff, size_t rowbytes) { return SLICE0 + loff + (size_t)gx * (SLICE - GTOK * rowbytes); }
__host__ __device__ __forceinline__ size_t loff_(int gx, size_t loff) { return SLICE0 + loff + (size_t)gx * SLICE; }

enum { I_X = 0, I_POS, I_MIXN, I_FFNN, I_WGU, I_WDN, I_SWIN, I_LRE, I_LIM, I_LSTEP, I_BRE, I_BIM, I_CRE, I_CIM, I_SD, I_SGLU,
       I_KVINN, I_WKVA, I_KVAN, I_WKVB, I_KNOPEN, I_KROPEN, I_WQA, I_QAN, I_WQB, I_QNOPEN, I_QROPEN, I_WO, N_IN };

__device__ __forceinline__ int opq_v(int v) { asm volatile("" : "+v"(v)); return v; }
__device__ __forceinline__ int opq_s(int v) { asm volatile("" : "+s"(v)); return v; }
__device__ __forceinline__ int lane_id_opq() { unsigned z = 0u; asm volatile("" : "+v"(z)); return (int)__builtin_amdgcn_mbcnt_hi(~0u, __builtin_amdgcn_mbcnt_lo(~0u, z)); }
__device__ __forceinline__ unsigned cvtpk(float lo, float hi) { f32x2_t v = {lo, hi}; bf16x2_t b = __builtin_convertvector(v, bf16x2_t); return __builtin_bit_cast(unsigned, b); }
__device__ __forceinline__ float bflo(unsigned w) { return __uint_as_float(w << 16); }
__device__ __forceinline__ float bfhi(unsigned w) { return __uint_as_float(w & 0xffff0000u); }
__device__ __forceinline__ float sigmoidf_(float x) { return __builtin_amdgcn_rcpf(1.0f + __builtin_amdgcn_exp2f(-1.4426950408889634f * x)); }
__device__ __forceinline__ float gelu_tanh(float x) { const float u = 1.5957691216057308f * (x + 0.044715f * x * x * x); return x * sigmoidf_(u); }

namespace pg8 {
constexpr int BM = 256, BK = 64, HALF = 128, HTB = HALF * BK * 2, STAGE_BYTES = 8 * HTB, NXCD = 8, WGM = 8;
__host__ __device__ __forceinline__ int lds_byte(int r, int c) { const int st = (r >> 4) * 2 + (c >> 5), rr = r & 15, cc = c & 31, ob = rr * 64 + cc * 2; return st * 1024 + (ob ^ (((ob >> 9) & 1) << 5)); }
__host__ __device__ __forceinline__ void stage_rc(int b, int& R, int& C) { const int st = b / 1024, sb = b % 1024, swz = sb ^ (((sb >> 9) & 1) << 5); R = (st >> 1) * 16 + swz / 64; C = (st & 1) * 32 + (swz % 64) / 2; }
__host__ __device__ __forceinline__ int perm32(int rho) { const int n = rho >> 4, i = rho & 15; return 8 * (i >> 2) + 4 * n + (i & 3); }

struct Unit { int pm, pn, pg; };
struct Gemm { const bf16_t* A; const bf16_t* Bt; int K, lda, ldb; long gsA, gsB; };

struct Sched {
    int nM, nN, nwg, nG, G, c, mode;
    __device__ void init(int M, int N, int nG_, int G_, int c_) { nM = M / BM; nN = N / BM; nwg = nM * nN; nG = nG_; G = G_; c = c_; mode = 0; }
    __device__ void init_local(int mode_, int c_) { nM = nN = nwg = nG = 1; G = 256; c = c_; mode = mode_; }
    __device__ bool next(int i, Unit& u) const {
        if (mode == 1) { if (i >= 4) return false; const int j = (c >> 3) + 32 * i; u.pg = j >> 1; u.pm = j & 1; u.pn = 0; return true; }
        if (mode == 2) { if (i >= 4) return false; const int j = (c >> 3) + 32 * i; u.pg = 0; u.pm = j & 3; u.pn = 32 * (c & 7) + (j >> 2); return true; }
        const long L = (long)i * G + c; if (L >= (long)nwg * nG) return false;
        u.pg = (int)(L / nwg); int wgid = (int)(L % nwg);
        { const int q = nwg / NXCD, r = nwg % NXCD, xcd = wgid % NXCD, off = wgid / NXCD; wgid = (xcd < r ? xcd * (q + 1) : r * (q + 1) + (xcd - r) * q) + off; }
        const int nig = WGM * nN, gid = wgid / nig, fm = gid * WGM, gsz = (nM - fm) < WGM ? (nM - fm) : WGM;
        u.pm = fm + ((wgid % nig) % gsz); u.pn = (wgid % nig) / gsz; return true;
    }
};

template <class Epi, bool ALIGN_EPI>
__device__ __forceinline__ void gemm_phase(LAS unsigned char* lds, const Gemm g, const Sched& S, const Epi& E, int tid_in) {
    int tid_ = tid_in; asm volatile("" : "+v"(tid_));
    const int tid = tid_, wid = __builtin_amdgcn_readfirstlane(tid >> 6), lane = tid & 63, wr = wid >> 2, wc = wid & 3, fr = lane & 15, fq = lane >> 4;
    const int K = g.K, nt = K / BK;
    unsigned voffA[2], voffB[2];
#pragma unroll
    for (int i = 0; i < 2; ++i) { int R, C; stage_rc(tid * 16 + i * 8192, R, C); const int Rb = (R & ~31) + perm32(R & 31);
        voffA[i] = (unsigned)(R * g.lda + C) * 2u; voffB[i] = (unsigned)(Rb * g.ldb + C) * 2u; }
    const size_t kstep = (size_t)(BK * 2);
    const size_t hsA = (size_t)HALF * g.lda * 2, hsB = (size_t)HALF * g.ldb * 2;
    const size_t tsA = 2 * hsA, tsB = 2 * hsB;
    const unsigned ldsw = (unsigned)wid * 1024u;
    const int aoff = lds_byte(wr * 64 + fr, fq * 8), boff = lds_byte(wc * 32 + fr, fq * 8);
#define PG8_SA(b, h) (((b) * 2 + (h)) * HTB)
#define PG8_SB(b, h) ((4 + (b) * 2 + (h)) * HTB)
#define PG8_STAGE(bufoff, gbase, voff) do { _Pragma("unroll") for (int _i = 0; _i < 2; ++_i) \
        __builtin_amdgcn_global_load_lds((const unsigned*)((const char*)(gbase) + (voff)[_i]), (LAS unsigned*)(lds + (bufoff) + ldsw + _i * 8192), 16, 0, 0); } while (0)
#define PG8_LDA(dst, b, h) do { _Pragma("unroll") for (int m = 0; m < 4; ++m) _Pragma("unroll") for (int k = 0; k < 2; ++k) dst[m][k] = *(const LAS bf16x8*)(lds + PG8_SA(b, h) + aoff + m * 2048 + k * 1024); } while (0)
#define PG8_LDB(dst, b, h) do { _Pragma("unroll") for (int n = 0; n < 2; ++n) _Pragma("unroll") for (int k = 0; k < 2; ++k) dst[n][k] = *(const LAS bf16x8*)(lds + PG8_SB(b, h) + boff + n * 2048 + k * 1024); } while (0)
#define PG8_MMA(ai, bj, At, Bt) do { __builtin_amdgcn_s_setprio(1); _Pragma("unroll") for (int m = 0; m < 4; ++m) _Pragma("unroll") for (int n = 0; n < 2; ++n) _Pragma("unroll") for (int k = 0; k < 2; ++k) \
        acc[ai][bj][m][n] = __builtin_amdgcn_mfma_f32_16x16x32_bf16(Bt[n][k], At[m][k], acc[ai][bj][m][n], 0, 0, 0); __builtin_amdgcn_s_setprio(0); } while (0)
#define PG8_WAIT_V(n) asm volatile("s_waitcnt vmcnt(" #n ")" ::: "memory")
#define PG8_WAIT_L(n) asm volatile("s_waitcnt lgkmcnt(" #n ")" ::: "memory")
#define PG8_BAR __builtin_amdgcn_s_barrier()
#define PG8_SCHED __builtin_amdgcn_sched_barrier(0)
    Unit cur, nxt; int ui = 0;
    if (!S.next(0, cur)) return;
    f32x4 acc[2][2][4][2];
#pragma unroll
    for (int a = 0; a < 2; ++a)
#pragma unroll
        for (int b = 0; b < 2; ++b)
#pragma unroll
            for (int m = 0; m < 4; ++m)
#pragma unroll
                for (int n = 0; n < 2; ++n) acc[a][b][m][n] = (f32x4){0.f, 0.f, 0.f, 0.f};
    bf16x8 At[4][2], B0[2][2], B1[2][2];
    const char* cA = (const char*)(g.A + (size_t)cur.pg * g.gsA) + (size_t)cur.pm * tsA;
    const char* cB = (const char*)(g.Bt + (size_t)cur.pg * g.gsB) + (size_t)cur.pn * tsB;
    PG8_STAGE(PG8_SB(0, 0), cB, voffB); PG8_STAGE(PG8_SB(0, 1), cB + hsB, voffB); PG8_STAGE(PG8_SA(0, 0), cA, voffA); PG8_STAGE(PG8_SA(0, 1), cA + hsA, voffA);
    if (wr == 1) PG8_BAR;
    PG8_WAIT_V(2); PG8_BAR;
    PG8_STAGE(PG8_SB(1, 0), cB + kstep, voffB); PG8_STAGE(PG8_SA(1, 0), cA + kstep, voffA); PG8_STAGE(PG8_SB(1, 1), cB + hsB + kstep, voffB);
    PG8_WAIT_V(6); PG8_BAR;
    for (;;) {
        const bool has_next = S.next(ui + 1, nxt);
        const char* nA = has_next ? (const char*)(g.A + (size_t)nxt.pg * g.gsA) + (size_t)nxt.pm * tsA : cA;
        const char* nB = has_next ? (const char*)(g.Bt + (size_t)nxt.pg * g.gsB) + (size_t)nxt.pn * tsB : cB;
        for (int t = 0; t < nt; t += 2) {
            const bool last = (t == nt - 2);
            const char* a1 = cA + (size_t)(t + 1) * kstep;
            const char* a2 = last ? nA : cA + (size_t)(t + 2) * kstep; const char* b2 = last ? nB : cB + (size_t)(t + 2) * kstep;
            const char* a3 = a2 + kstep; const char* b3 = b2 + kstep;
            PG8_LDB(B0, 0, 0); PG8_LDB(B1, 0, 1); PG8_SCHED; PG8_LDA(At, 0, 0); PG8_STAGE(PG8_SA(1, 1), a1 + hsA, voffA);
            PG8_WAIT_V(8); PG8_WAIT_L(0); PG8_BAR; PG8_MMA(0, 0, At, B0); PG8_MMA(0, 1, At, B1); PG8_BAR; PG8_SCHED;
            PG8_LDA(At, 0, 1); PG8_STAGE(PG8_SB(0, 0), b2, voffB); PG8_STAGE(PG8_SB(0, 1), b2 + hsB, voffB); PG8_STAGE(PG8_SA(0, 0), a2, voffA);
            PG8_WAIT_V(8); PG8_WAIT_L(0); PG8_BAR; PG8_MMA(1, 0, At, B0); PG8_MMA(1, 1, At, B1); PG8_BAR; PG8_SCHED;
            PG8_LDB(B0, 1, 0); PG8_LDB(B1, 1, 1); PG8_SCHED; PG8_LDA(At, 1, 0); PG8_STAGE(PG8_SA(0, 1), a2 + hsA, voffA);
            PG8_WAIT_V(8); PG8_WAIT_L(0); PG8_BAR; PG8_MMA(0, 0, At, B0); PG8_MMA(0, 1, At, B1); PG8_BAR; PG8_SCHED;
            PG8_LDA(At, 1, 1); PG8_STAGE(PG8_SB(1, 0), b3, voffB); PG8_STAGE(PG8_SB(1, 1), b3 + hsB, voffB); PG8_STAGE(PG8_SA(1, 0), a3, voffA);
            PG8_WAIT_V(8); PG8_WAIT_L(0); PG8_BAR; PG8_MMA(1, 0, At, B0); PG8_MMA(1, 1, At, B1); PG8_BAR; PG8_SCHED;
        }
        if constexpr (ALIGN_EPI) { if (wr == 0) PG8_BAR; }
        E(acc, cur, wr, wc, fr, fq);
        if (!has_next) break;
#pragma unroll
        for (int a = 0; a < 2; ++a)
#pragma unroll
            for (int b = 0; b < 2; ++b)
#pragma unroll
                for (int m = 0; m < 4; ++m)
#pragma unroll
                    for (int n = 0; n < 2; ++n) acc[a][b][m][n] = (f32x4){0.f, 0.f, 0.f, 0.f};
        cur = nxt; cA = nA; cB = nB; ++ui;
        if constexpr (ALIGN_EPI) { if (wr == 1) PG8_BAR; }
    }
    PG8_WAIT_V(0);
    if constexpr (!ALIGN_EPI) { if (wr == 0) PG8_BAR; }
    PG8_BAR;
#undef PG8_SA
#undef PG8_SB
#undef PG8_STAGE
#undef PG8_LDA
#undef PG8_LDB
#undef PG8_MMA
#undef PG8_WAIT_V
#undef PG8_WAIT_L
#undef PG8_BAR
#undef PG8_SCHED
}

struct RowScale {
    const float* slots; int s0, npf; float inv_n;
    __device__ __forceinline__ float get(int row, int fq) const {
        const float* p = slots + (size_t)row * 32 + s0 + fq * npf; float s = 0.f;
        for (int i = 0; i < npf; ++i) s += p[i];
        s += __shfl_xor(s, 16); s += __shfl_xor(s, 32);
        return rsqrtf(s * inv_n + EPS);
    }
};
__device__ __forceinline__ float ssq8(const f32x4& a, const f32x4& b) { return (a[0] * a[0] + a[1] * a[1]) + (a[2] * a[2] + a[3] * a[3]) + (b[0] * b[0] + b[1] * b[1]) + (b[2] * b[2] + b[3] * b[3]); }
__device__ __forceinline__ u32x4 pack8(const f32x4& a, const f32x4& b) { u32x4 w; w.x = cvtpk(a[0], a[1]); w.y = cvtpk(a[2], a[3]); w.z = cvtpk(b[0], b[1]); w.w = cvtpk(b[2], b[3]); return w; }

template <int MODE, bool SSQ> struct EpiScaleBf16 {
    bf16_t* O; int ldc; RowScale rs; float* ssq;
    __device__ __forceinline__ void operator()(const f32x4 (&acc)[2][2][4][2], const Unit& u, int wr, int wc, int fr, int fq) const {
        { const int l_ = lane_id_opq(); fr = l_ & 15; fq = l_ >> 4; }
        const int row0 = u.pm * BM + wr * 64 + fr, colb = u.pn * BM + wc * 32 + 8 * fq;
#pragma unroll
        for (int ai = 0; ai < 2; ++ai)
#pragma unroll
            for (int m = 0; m < 4; ++m) { const int row = row0 + ai * HALF + m * 16; const float r = rs.get(row, fq);
#pragma unroll
                for (int bj = 0; bj < 2; ++bj) { const int col = colb + bj * HALF; const f32x4 v0 = acc[ai][bj][m][0] * r, v1 = acc[ai][bj][m][1] * r;
                    bf16_t* p = (MODE == 0) ? O + (size_t)row * ldc + col : O + ((size_t)(col >> 4) * 512 + (row >> 4)) * 384 + (row & 15) * 16 + (col & 15);
                    *(u32x4*)p = pack8(v0, v1);
                    if (SSQ) { float s = ssq8(v0, v1); s += __shfl_xor(s, 16); s += __shfl_xor(s, 32); if (fq == 0) ssq[(size_t)row * 32 + (u.pn * 2 + bj) * 4 + wc] = s; } }
                asm volatile("" ::: "memory"); }
    }
};
template <bool GLU> struct EpiRes {
    float* xout; bf16_t* xb; float* ssq; bool wf32;
    __device__ __forceinline__ void operator()(const f32x4 (&acc)[2][2][4][2], const Unit& u, int wr, int wc, int fr, int fq) const {
        { const int l_ = lane_id_opq(); fr = l_ & 15; fq = l_ >> 4; }
        const int row0 = u.pm * BM + wr * 64 + fr;
#pragma unroll
        for (int ai = 0; ai < 2; ++ai)
#pragma unroll
            for (int m = 0; m < 4; ++m) { const int row = row0 + ai * HALF + m * 16;
#pragma unroll
                for (int bj = 0; bj < (GLU ? 1 : 2); ++bj) { f32x4 v0, v1; int col, slot;
                    if (GLU) { col = u.pn * HALF + wc * 32 + 8 * fq; slot = u.pn * 4 + wc;
#pragma unroll
                        for (int e = 0; e < 4; ++e) { v0[e] = acc[ai][0][m][0][e] * sigmoidf_(acc[ai][1][m][0][e]); v1[e] = acc[ai][0][m][1][e] * sigmoidf_(acc[ai][1][m][1][e]); }
                    } else { col = u.pn * BM + bj * HALF + wc * 32 + 8 * fq; slot = (u.pn * 2 + bj) * 4 + wc; v0 = acc[ai][bj][m][0]; v1 = acc[ai][bj][m][1]; }
                    const size_t p = (size_t)row * DM + col; const u32x4 xw = *(const u32x4*)(xb + p);
                    const f32x4 x0 = (f32x4){bflo(xw.x), bfhi(xw.x), bflo(xw.y), bfhi(xw.y)} + v0, x1 = (f32x4){bflo(xw.z), bfhi(xw.z), bflo(xw.w), bfhi(xw.w)} + v1;
                    if (wf32) { *(f32x4*)(xout + p) = x0; *(f32x4*)(xout + p + 4) = x1; }
                    *(u32x4*)(xb + p) = pack8(x0, x1);
                    float s = ssq8(x0, x1); s += __shfl_xor(s, 16); s += __shfl_xor(s, 32); if (fq == 0) ssq[(size_t)row * 32 + slot] = s; }
                asm volatile("" ::: "memory"); }
    }
};
struct EpiSwiGLU {
    bf16_t* O; RowScale rs;
    __device__ __forceinline__ void operator()(const f32x4 (&acc)[2][2][4][2], const Unit& u, int wr, int wc, int fr, int fq) const {
        { const int l_ = lane_id_opq(); fr = l_ & 15; fq = l_ >> 4; }
        const int row0 = u.pm * BM + wr * 64 + fr, col = u.pn * HALF + wc * 32 + 8 * fq;
#pragma unroll
        for (int ai = 0; ai < 2; ++ai)
#pragma unroll
            for (int m = 0; m < 4; ++m) { const int row = row0 + ai * HALF + m * 16; const float r = rs.get(row, fq); f32x4 v0, v1;
#pragma unroll
                for (int e = 0; e < 4; ++e) { const float g0 = acc[ai][0][m][0][e] * r, g1 = acc[ai][0][m][1][e] * r;
                    v0[e] = g0 * sigmoidf_(g0) * (acc[ai][1][m][0][e] * r); v1[e] = g1 * sigmoidf_(g1) * (acc[ai][1][m][1][e] * r); }
                *(u32x4*)(O + (size_t)row * FF + col) = pack8(v0, v1); asm volatile("" ::: "memory"); }
    }
};
struct EpiSsmP {
    float* W;
    __device__ __forceinline__ void operator()(const f32x4 (&acc)[2][2][4][2], const Unit& u, int wr, int wc, int fr, int fq) const {
        { const int l_ = lane_id_opq(); fr = l_ & 15; fq = l_ >> 4; }
        const int row0 = u.pm * BM + wr * 64 + fr;
#pragma unroll
        for (int ai = 0; ai < 2; ++ai)
#pragma unroll
            for (int m = 0; m < 4; ++m) { const int row = row0 + ai * HALF + m * 16; float* p = W + ((size_t)u.pg * 512 + row) * 128 + wc * 32 + 8 * fq;
                *(f32x4*)p = acc[ai][0][m][0]; *(f32x4*)(p + 4) = acc[ai][0][m][1]; }
    }
};
struct EpiSsmY {
    const bf16_t* Ag; const float* dskip; bf16_t* z;
    __device__ __forceinline__ void operator()(const f32x4 (&acc)[2][2][4][2], const Unit& u, int wr, int wc, int fr, int fq) const {
        { const int l_ = lane_id_opq(); fr = l_ & 15; fq = l_ >> 4; }
        const int row0 = u.pm * BM + wr * 64 + fr, k0 = (fq & 1) * 8;
#pragma unroll
        for (int ai = 0; ai < 2; ++ai)
#pragma unroll
            for (int m = 0; m < 4; ++m) { const int row = row0 + ai * HALF + m * 16;
#pragma unroll
                for (int bj = 0; bj < 2; ++bj) { const int col = bj * HALF + wc * 32 + 8 * fq, t = col >> 4;
                    const u32x4 uw = *(const u32x4*)(Ag + ((size_t)u.pg * 512 + row) * 384 + col);
                    const f32x4 d0 = *(const f32x4*)(dskip + u.pg * 16 + k0), d1 = *(const f32x4*)(dskip + u.pg * 16 + k0 + 4);
                    f32x4 y0 = acc[ai][bj][m][0], y1 = acc[ai][bj][m][1];
                    y0[0] += d0[0] * bflo(uw.x); y0[1] += d0[1] * bfhi(uw.x); y0[2] += d0[2] * bflo(uw.y); y0[3] += d0[3] * bfhi(uw.y);
                    y1[0] += d1[0] * bflo(uw.z); y1[1] += d1[1] * bfhi(uw.z); y1[2] += d1[2] * bflo(uw.w); y1[3] += d1[3] * bfhi(uw.w);
#pragma unroll
                    for (int e = 0; e < 4; ++e) { y0[e] = gelu_tanh(y0[e]); y1[e] = gelu_tanh(y1[e]); }
                    *(u32x4*)(z + ((size_t)row * 16 + t) * DM + u.pg * 16 + k0) = pack8(y0, y1); asm volatile("" ::: "memory"); } }
    }
};
struct EpiHead {
    bf16_t* O; RowScale rs; const float* gn; const float* gr; const float* rc; const float* rsn; float osc; int pitch, hs;
    __device__ __forceinline__ void operator()(const f32x4 (&acc)[2][2][4][2], const Unit& u, int wr, int wc, int fr, int fq) const {
        { const int l_ = lane_id_opq(); fr = l_ & 15; fq = l_ >> 4; }
        const int row0 = u.pm * BM + wr * 64 + fr;
        if (u.pn < 4) { const int h = 4 * u.pn + wc;
#pragma unroll
            for (int ai = 0; ai < 2; ++ai)
#pragma unroll
                for (int m = 0; m < 4; ++m) { const int row = row0 + ai * HALF + m * 16; const float r = rs.get(row, fq);
                    const f32x4 a0 = acc[ai][0][m][0] * r, a1 = acc[ai][0][m][1] * r, b0 = acc[ai][1][m][0] * r, b1 = acc[ai][1][m][1] * r;
                    float s = ssq8(a0, a1) + ssq8(b0, b1); s += __shfl_xor(s, 16); s += __shfl_xor(s, 32);
                    const float rh = rsqrtf(s * (1.0f / 64) + EPS) * osc;
                    bf16_t* p = O + (size_t)row * pitch + h * hs + 8 * fq;
                    { const f32x4 g0 = *(const f32x4*)(gn + 8 * fq), g1 = *(const f32x4*)(gn + 8 * fq + 4); *(u32x4*)p = pack8(a0 * g0 * rh, a1 * g1 * rh); }
                    { const f32x4 g0 = *(const f32x4*)(gn + 32 + 8 * fq), g1 = *(const f32x4*)(gn + 32 + 8 * fq + 4); *(u32x4*)(p + 32) = pack8(b0 * g0 * rh, b1 * g1 * rh); }
                    asm volatile("" ::: "memory"); }
        } else { const int h = 8 * (u.pn - 4) + 2 * wc + (fq >> 1), i0 = (fq & 1) * 8;
#pragma unroll
            for (int ai = 0; ai < 2; ++ai)
#pragma unroll
                for (int m = 0; m < 4; ++m) { const int row = row0 + ai * HALF + m * 16; const float r = rs.get(row, fq);
                    f32x4 x1a = acc[ai][0][m][0] * r, x1b = acc[ai][0][m][1] * r, x2a = acc[ai][1][m][0] * r, x2b = acc[ai][1][m][1] * r;
                    float s = ssq8(x1a, x1b) + ssq8(x2a, x2b); s += __shfl_xor(s, 16);
                    const float rh = rsqrtf(s * (1.0f / 32) + EPS);
                    x1a = x1a * *(const f32x4*)(gr + i0) * rh; x1b = x1b * *(const f32x4*)(gr + i0 + 4) * rh; x2a = x2a * *(const f32x4*)(gr + 16 + i0) * rh; x2b = x2b * *(const f32x4*)(gr + 16 + i0 + 4) * rh;
                    const f32x4 ca = *(const f32x4*)(rc + (size_t)row * 16 + i0) * osc, cb = *(const f32x4*)(rc + (size_t)row * 16 + i0 + 4) * osc, sa = *(const f32x4*)(rsn + (size_t)row * 16 + i0) * osc, sb = *(const f32x4*)(rsn + (size_t)row * 16 + i0 + 4) * osc;
                    bf16_t* p = O + (size_t)row * pitch + h * hs + 64 + i0;
                    *(u32x4*)p = pack8(x1a * ca - x2a * sa, x1b * cb - x2b * sb);
                    *(u32x4*)(p + 16) = pack8(x1a * sa + x2a * ca, x1b * sb + x2b * cb);
                    asm volatile("" ::: "memory"); }
        }
    }
};
struct EpiVt {
    bf16_t* Vt; const float* slots2;
    __device__ __forceinline__ void operator()(const f32x4 (&acc)[2][2][4][2], const Unit& u, int wr, int wc, int fr, int fq) const {
        { const int l_ = lane_id_opq(); fr = l_ & 15; fq = l_ >> 4; }
        const int row0 = u.pm * BM + wr * 64 + fr;
#pragma unroll
        for (int bj = 0; bj < 2; ++bj) { const int tok0 = u.pn * BM + bj * HALF + wc * 32 + 8 * fq, b = tok0 >> 11, l = tok0 & 2047;
            float rt[8];
#pragma unroll
            for (int e = 0; e < 8; ++e) { const float* p = slots2 + (size_t)(tok0 + e) * 32 + 12; const f32x4 a = *(const f32x4*)p, b2 = *(const f32x4*)(p + 4);
                rt[e] = rsqrtf(((a[0] + a[1]) + (a[2] + a[3]) + (b2[0] + b2[1]) + (b2[2] + b2[3])) * (1.0f / 256) + EPS);
                if ((e & 1) == 1) asm volatile("" ::: "memory"); }
#pragma unroll
            for (int ai = 0; ai < 2; ++ai)
#pragma unroll
                for (int m = 0; m < 4; ++m) { const int row = row0 + ai * HALF + m * 16;
                    f32x4 v0 = acc[ai][bj][m][0], v1 = acc[ai][bj][m][1];
#pragma unroll
                    for (int e = 0; e < 4; ++e) { v0[e] *= rt[e]; v1[e] *= rt[4 + e]; }
                    *(u32x4*)(Vt + ((size_t)(b * 1024 + row)) * SEQ + l) = pack8(v0, v1); }
            asm volatile("" ::: "memory"); }
    }
};
}

struct Args { const float* in[N_IN]; float* out; unsigned char* ws; int ph_lo, ph_hi; };

__device__ __forceinline__ void sincos_rev(double rev, float& sn, float& cs) {
    const double fr = rev - rint(rev); const double q = rint(4.0 * fr); const double y = fr - 0.25 * q; const double x = 6.283185307179586 * y, x2 = x * x;
    const double s = x * (1.0 + x2 * (-1.0 / 6 + x2 * (1.0 / 120 + x2 * (-1.0 / 5040 + x2 * (1.0 / 362880 + x2 * (-1.0 / 39916800 + x2 * (1.0 / 6227020800.0)))))));
    const double c = 1.0 + x2 * (-0.5 + x2 * (1.0 / 24 + x2 * (-1.0 / 720 + x2 * (1.0 / 40320 + x2 * (-1.0 / 3628800 + x2 * (1.0 / 479001600.0 + x2 * (-1.0 / 87178291200.0)))))));
    const int qi = ((int)q) & 3;
    const double ss = (qi == 0) ? s : (qi == 1) ? c : (qi == 2) ? -s : -c;
    const double cc = (qi == 0) ? c : (qi == 1) ? -s : (qi == 2) ? -c : s;
    sn = (float)ss; cs = (float)cc;
}

__device__ __forceinline__ void tr_item(const float* W, int K, int N, const float* gain, bf16_t* dst, int ldk, int mode, int H, int drow0, LAS float* scr, int item, int lane) {
    const int nblk = N / 32, kb = item / nblk, nb = item % nblk, k0 = 64 * kb, n0 = 32 * nb;
#pragma unroll 8
    for (int i = 0; i < 32; ++i) { const int kk = 2 * i + (lane >> 5); float v = W[(size_t)(k0 + kk) * N + n0 + (lane & 31)]; if (gain) v *= gain[k0 + kk]; scr[kk * 33 + (lane & 31)] = v; }
    asm volatile("s_waitcnt lgkmcnt(0)" ::: "memory");
    int drow, extra16 = 0;
    if (mode == 0) drow = drow0 + n0;
    else if (mode == 1) { const int half = n0 / H, j = n0 % H; drow = drow0 + (j / 128) * 256 + half * 128 + (j % 128); }
    else if (mode == 2) { const int h = n0 / 128, part = (n0 % 128) / 32;
        drow = (part < 2) ? (h / 4) * 256 + part * 128 + (h % 4) * 32 : 1024 + h * 64 + (part - 2) * 32; }
    else { const int h = n0 / 96, part = (n0 % 96) / 32;
        if (part < 2) drow = (h / 4) * 256 + part * 128 + (h % 4) * 32; else { drow = 1024 + (h / 8) * 256 + ((h % 8) / 2) * 32 + (h % 2) * 16; extra16 = 112; } }
    const int c = lane & 7;
#pragma unroll
    for (int j = 0; j < 4; ++j) { const int n = (lane >> 3) + 8 * j; const LAS float* s = scr + (8 * c) * 33 + n;
        u32x4 o; o.x = cvtpk(s[0 * 33], s[1 * 33]); o.y = cvtpk(s[2 * 33], s[3 * 33]); o.z = cvtpk(s[4 * 33], s[5 * 33]); o.w = cvtpk(s[6 * 33], s[7 * 33]);
        *(u32x4*)(dst + (size_t)(drow + n + (n >= 16 ? extra16 : 0)) * ldk + k0 + 8 * c) = o; }
    asm volatile("s_waitcnt lgkmcnt(0)" ::: "memory");
}

__device__ __forceinline__ void ssm_precompute(const Args& a, LAS unsigned char* lds, int job, int tid_in) {
    const int tid = opq_v(tid_in), i = job >> 6, g = job & 63, ig = i * 64 + g;
    LAS float* apr = (LAS float*)lds;
    LAS float* api = apr + 17 * 64;
    LAS float* bbr = api + 17 * 64;
    LAS float* bbi = bbr + 1024;
    LAS float* ccr = bbi + 1024;
    LAS float* cci = ccr + 1024;
    LAS float* kern = cci + 1024;
    const float* lam_re = a.in[I_LRE] + (size_t)ig * 64; const float* lam_im = a.in[I_LIM] + (size_t)ig * 64;
    const double step = exp((double)a.in[I_LSTEP][ig]);
    __syncthreads();
    for (int idx = tid; idx < 17 * 64; idx += 512) { const int d = idx >> 6, n = idx & 63;
        const double lr = (double)lam_re[n], li = (double)lam_im[n];
        const double mag = exp(lr * step * d); float sn, cs; sincos_rev(li * step * d * 0.15915494309189535, sn, cs);
        apr[idx] = (float)(mag * cs); api[idx] = (float)(mag * sn); }
    for (int idx = tid; idx < 1024; idx += 512) { ccr[idx] = a.in[I_CRE][(size_t)ig * 1024 + idx]; cci[idx] = a.in[I_CIM][(size_t)ig * 1024 + idx]; }
    __syncthreads();
    for (int idx = tid; idx < 1024; idx += 512) { const int n = idx >> 4;
        const float lr = lam_re[n], li = lam_im[n], are = apr[64 + n], aim = api[64 + n], den = lr * lr + li * li;
        const float fre = ((are - 1.0f) * lr + aim * li) / den, fim = (aim * lr - (are - 1.0f) * li) / den;
        const float br = a.in[I_BRE][(size_t)ig * 1024 + idx], bi = a.in[I_BIM][(size_t)ig * 1024 + idx];
        bbr[idx] = fre * br - fim * bi; bbi[idx] = fre * bi + fim * br; }
    __syncthreads();
    for (int idx = tid; idx < 4096; idx += 512) { const int d = idx >> 8, k = (idx >> 4) & 15, kp = idx & 15; float s = 0.f;
        for (int n = 0; n < 64; ++n) { const float pr = apr[d * 64 + n], pi = api[d * 64 + n], br = bbr[n * 16 + kp], bi = bbi[n * 16 + kp];
            const float tr = pr * br - pi * bi, ti = pr * bi + pi * br; s += ccr[k * 64 + n] * tr - cci[k * 64 + n] * ti; }
        kern[idx] = s; }
    __syncthreads();
    bf16_t* bty = (bf16_t*)(a.ws + WS_BTY) + (size_t)ig * 256 * 384;
    for (int idx = tid; idx < 256 * 384; idx += 512) { const int row = idx / 384, col = idx % 384, t = row >> 4, k = row & 15; float v;
        if (col < 256) { const int j = col >> 4, kp = col & 15; v = (j <= t) ? kern[(t - j) * 256 + k * 16 + kp] : 0.f; }
        else if (col < 320) { const int n = col - 256; v = ccr[k * 64 + n] * apr[(t + 1) * 64 + n] - cci[k * 64 + n] * api[(t + 1) * 64 + n]; }
        else { const int n = col - 320; v = -(ccr[k * 64 + n] * api[(t + 1) * 64 + n] + cci[k * 64 + n] * apr[(t + 1) * 64 + n]); }
        bty[idx] = (bf16_t)(cvtpk(v, 0.f) & 0xffffu); }
    bf16_t* btp = (bf16_t*)(a.ws + WS_BTP) + (size_t)ig * 256 * 256;
    for (int idx = tid; idx < 256 * 256; idx += 512) { const int row = idx >> 8, col = idx & 255, j = col >> 4, kp = col & 15; float v = 0.f;
        if (row < 128) { const int n = row & 63; const float pr = apr[(15 - j) * 64 + n], pi = api[(15 - j) * 64 + n], br = bbr[n * 16 + kp], bi = bbi[n * 16 + kp];
            v = (row < 64) ? (pr * br - pi * bi) : (pr * bi + pi * br); }
        btp[idx] = (bf16_t)(cvtpk(v, 0.f) & 0xffffu); }
    float* ac = (float*)(a.ws + WS_AC) + (size_t)ig * 128;
    if (tid < 64) { ac[tid] = apr[16 * 64 + tid]; ac[64 + tid] = api[16 * 64 + tid]; }
    __syncthreads();
}

__device__ __forceinline__ void phase_setup(const Args& a, LAS unsigned char* lds, int tid_in) {
    const int tid = opq_v(tid_in), lane = tid & 63, wave = tid >> 6, G = opq_s(gridDim.x), bx = opq_s(blockIdx.x);
    for (int job = bx; job < 128; job += G) ssm_precompute(a, lds, job, tid_in);
    __syncthreads();
    LAS float* scr = (LAS float*)(lds + wave * 8448);
    const int gw = bx * 8 + wave, NGW = G * 8;
    unsigned char* ws = a.ws;
    constexpr int I_GU = 16 * 176, I_DN = 44 * 32, I_IN = 16 * 32, I_GL = 16 * 64, I_QA = 16 * 12, I_KVA = 16 * 9, I_QB = 6 * 48, I_KVB = 4 * 64, I_O = 16 * 32;
    constexpr int NITEMS = 4 * I_GU + 4 * I_DN + 2 * I_IN + 2 * I_GL + 2 * I_QA + I_KVA + 2 * I_QB + I_KVB + 2 * I_O;
    for (int it = gw; it < NITEMS; it += NGW) {
        int r = it;
        if (r < 4 * I_GU) { const int l = r / I_GU; tr_item(a.in[I_WGU] + (size_t)l * DM * 2 * FF, DM, 2 * FF, a.in[I_FFNN] + l * DM, (bf16_t*)(ws + WS_WGU) + (size_t)l * 2 * FF * DM, DM, 1, FF, 0, scr, r % I_GU, lane); continue; } r -= 4 * I_GU;
        if (r < 4 * I_DN) { const int l = r / I_DN; tr_item(a.in[I_WDN] + (size_t)l * FF * DM, FF, DM, nullptr, (bf16_t*)(ws + WS_WDN) + (size_t)l * DM * FF, FF, 0, 1, 0, scr, r % I_DN, lane); continue; } r -= 4 * I_DN;
        if (r < 2 * I_IN) { const int l = r / I_IN; tr_item(a.in[I_SWIN] + (size_t)l * DM * DM, DM, DM, a.in[I_MIXN] + l * DM, (bf16_t*)(ws + WS_WIN) + (size_t)l * DM * DM, DM, 0, 1, 0, scr, r % I_IN, lane); continue; } r -= 2 * I_IN;
        if (r < 2 * I_GL) { const int l = r / I_GL; tr_item(a.in[I_SGLU] + (size_t)l * DM * 2 * DM, DM, 2 * DM, nullptr, (bf16_t*)(ws + WS_WGLU) + (size_t)l * 2 * DM * DM, DM, 1, DM, 0, scr, r % I_GL, lane); continue; } r -= 2 * I_GL;
        if (r < I_QA) { tr_item(a.in[I_WQA], DM, 384, a.in[I_MIXN] + 2 * DM, (bf16_t*)(ws + WS_WQKVA), DM, 0, 1, 0, scr, r, lane); continue; } r -= I_QA;
        if (r < I_QA) { tr_item(a.in[I_WQA] + (size_t)DM * 384, DM, 384, a.in[I_MIXN] + 3 * DM, (bf16_t*)(ws + WS_WQA3), DM, 0, 1, 0, scr, r, lane); continue; } r -= I_QA;
        if (r < I_KVA) { tr_item(a.in[I_WKVA], DM, 288, a.in[I_KVINN], (bf16_t*)(ws + WS_WQKVA), DM, 0, 1, 384, scr, r, lane); continue; } r -= I_KVA;
        if (r < 2 * I_QB) { const int l = r / I_QB; tr_item(a.in[I_WQB] + (size_t)l * 384 * 1536, 384, 1536, a.in[I_QAN] + l * 384, (bf16_t*)(ws + WS_WQB) + (size_t)l * 1536 * 384, 384, 3, 1, 0, scr, r % I_QB, lane); continue; } r -= 2 * I_QB;
        if (r < I_KVB) { tr_item(a.in[I_WKVB], 256, 2048, a.in[I_KVAN], (bf16_t*)(ws + WS_WKVB), 256, 2, 1, 0, scr, r, lane); continue; } r -= I_KVB;
        { const int l = r / I_O; tr_item(a.in[I_WO] + (size_t)l * DM * DM, DM, DM, nullptr, (bf16_t*)(ws + WS_WO) + (size_t)l * DM * DM, DM, 0, 1, 0, scr, r % I_O, lane); }
    }
    { const int gt = bx * 512 + tid, NT_ = G * 512;
      u32x4* p0 = (u32x4*)((bf16_t*)(ws + WS_WQKVA) + (size_t)672 * DM); for (int i = gt; i < 96 * DM / 8; i += NT_) p0[i] = (u32x4){0u, 0u, 0u, 0u};
      u32x4* p1 = (u32x4*)((bf16_t*)(ws + WS_WQA3) + (size_t)384 * DM); for (int i = gt; i < 128 * DM / 8; i += NT_) p1[i] = (u32x4){0u, 0u, 0u, 0u};
      float* rc = (float*)(ws + WS_ROPE); float* rsn = rc + (size_t)T * 16; const int* pos = (const int*)a.in[I_POS];
      for (int i = gt; i < T * 16; i += NT_) { const int tok = i >> 4, f = i & 15; double inv = 1.0; for (int q = 0; q < f; ++q) inv *= 0.5623413251903491;
          float sn, cs; sincos_rev((double)pos[tok] * inv * 0.15915494309189535, sn, cs); rc[i] = cs; rsn[i] = sn; } }
    { const float* x = a.in[I_X]; bf16_t* xb = (bf16_t*)(ws + WS_XB); float* slots = (float*)(ws + WS_SLOT);
      for (int row = gw; row < T; row += NGW) { const f32x4* xr = (const f32x4*)(x + (size_t)row * DM) + lane; float s = 0.f;
#pragma unroll
          for (int j = 0; j < 4; ++j) { const f32x4 v = xr[64 * j]; s += (v[0] * v[0] + v[1] * v[1]) + (v[2] * v[2] + v[3] * v[3]);
              u32x2 w; w.x = cvtpk(v[0], v[1]); w.y = cvtpk(v[2], v[3]); *((u32x2*)(xb + (size_t)row * DM) + lane + 64 * j) = w; }
          s += __shfl_xor(s, 1); if ((lane & 1) == 0) slots[(size_t)row * 32 + (lane >> 1)] = s; } }
}

__device__ __forceinline__ void phase_scan(const Args& a, int layer, int tid_in) {
    const int bx_ = opq_s(blockIdx.x), gx = bx_ & 7;
    const float* W = (const float*)(a.ws + loff_(gx, L_WST)); bf16_t* Ag = (bf16_t*)(a.ws + loff_(gx, L_AG)); const float* ac = (const float*)(a.ws + WS_AC) + (size_t)layer * 64 * 128;
    for (int gt = (bx_ >> 3) * 512 + opq_v(tid_in); gt < 4 * 64 * 64; gt += 32 * 512) {
        const int n = gt & 63, g = (gt >> 6) & 63, b = gt >> 12;
        const float ar = ac[g * 128 + n], ai = ac[g * 128 + 64 + n]; float sr = 0.f, si = 0.f;
        const size_t row0 = (size_t)g * 512 + (size_t)b * 128;
        const float* w = W + row0 * 128 + n; bf16_t* o = Ag + row0 * 384 + 256 + n;
#pragma unroll 8
        for (int m = 0; m < 128; ++m) { const float wr_ = w[(size_t)m * 128], wi_ = w[(size_t)m * 128 + 64];
            o[(size_t)m * 384] = (bf16_t)(cvtpk(sr, 0.f) & 0xffffu); o[(size_t)m * 384 + 64] = (bf16_t)(cvtpk(si, 0.f) & 0xffffu);
            const float nr = ar * sr - ai * si + wr_, ni = ar * si + ai * sr + wi_; sr = nr; si = ni; }
    }
}

__device__ __forceinline__ void phase_krope(const Args& a, int tid_in) {
    unsigned char* ws = a.ws;
    const int bx_ = opq_s(blockIdx.x), gx = bx_ & 7;
    const bf16_t* qkva = (const bf16_t*)(ws + voff(gx, L_QKVA, 1536)); const float* slots2 = (const float*)(ws + WS_SLOT2);
    bf16_t* KR = (bf16_t*)(ws + voff(gx, L_KR, 64)); const float* rc = (const float*)(ws + WS_ROPE); const float* rsn = rc + (size_t)T * 16;
    const float* gkr = a.in[I_KROPEN];
    for (int gt = (bx_ >> 3) * 512 + opq_v(tid_in); gt < (int)GTOK * 4; gt += 32 * 512) { const int tok = gx * (int)GTOK + (gt >> 2), qd = gt & 3;
        const u32x2 w1 = *(const u32x2*)(qkva + (size_t)tok * 768 + 640 + 4 * qd), w2 = *(const u32x2*)(qkva + (size_t)tok * 768 + 656 + 4 * qd);
        const float r = rsqrtf(slots2[(size_t)tok * 32 + 20] * (1.0f / 32) + EPS);
        const float x1[4] = {bflo(w1.x), bfhi(w1.x), bflo(w1.y), bfhi(w1.y)}, x2[4] = {bflo(w2.x), bfhi(w2.x), bflo(w2.y), bfhi(w2.y)}; float o1[4], o2[4];
#pragma unroll
        for (int e = 0; e < 4; ++e) { const int i = 4 * qd + e; const float a1 = x1[e] * r * gkr[i], a2 = x2[e] * r * gkr[16 + i], c = rc[(size_t)tok * 16 + i], s = rsn[(size_t)tok * 16 + i];
            o1[e] = a1 * c - a2 * s; o2[e] = a1 * s + a2 * c; }
        u32x2 p1, p2; p1.x = cvtpk(o1[0], o1[1]); p1.y = cvtpk(o1[2], o1[3]); p2.x = cvtpk(o2[0], o2[1]); p2.y = cvtpk(o2[2], o2[3]);
        *(u32x2*)(KR + (size_t)tok * 32 + 4 * qd) = p1; *(u32x2*)(KR + (size_t)tok * 32 + 16 + 4 * qd) = p2; }
}

__device__ __forceinline__ int crow(int r, int hi) { return (r & 3) + 8 * (r >> 2) + 4 * hi; }
constexpr int AT_KROW = 208, AT_KBUF = 64 * AT_KROW, AT_VROW = 136, AT_VBUF = 64 * AT_VROW, AT_VOFF = 2 * AT_KBUF;
template <bool FIXED>
__device__ __forceinline__ void attn_unit(LAS unsigned char* lds, const bf16_t* Q, const bf16_t* Kf, const bf16_t* KR, const bf16_t* Vt, bf16_t* O, int b, int h, int qb, int tid_in, float negB) {
    const int tid = opq_v(tid_in), lane = tid & 63, r32 = lane & 31, hi = lane >> 5; const int wid = __builtin_amdgcn_readfirstlane(tid >> 6);
    const int q0 = qb * 256; const size_t rowbase = (size_t)b * SEQ;
    const int qabs = q0 + wid * 32 + r32;
    bf16x8 qf[6];
    { const bf16_t* qp = Q + (rowbase + qabs) * 1536 + h * 96 + hi * 8;
#pragma unroll
      for (int s = 0; s < 6; ++s) qf[s] = *(const bf16x8*)(qp + 16 * s); }
    const int NT_ = (q0 + 256) / 64;
    const int kr0 = tid / 12, kp0 = tid % 12, kr1 = (512 + tid) / 12, kp1 = (512 + tid) % 12; const bool k2 = tid < 256;
    const bf16_t* kg0 = (kp0 < 8) ? Kf + (rowbase + kr0) * 1024 + h * 64 + kp0 * 8 : KR + (rowbase + kr0) * 32 + (kp0 - 8) * 8;
    const bf16_t* kg1 = (kp1 < 8) ? Kf + (rowbase + kr1) * 1024 + h * 64 + kp1 * 8 : KR + (rowbase + kr1) * 32 + (kp1 - 8) * 8;
    const size_t ks0 = (kp0 < 8) ? (size_t)64 * 1024 : (size_t)64 * 32, ks1 = (kp1 < 8) ? (size_t)64 * 1024 : (size_t)64 * 32;
    const int kl0 = kr0 * AT_KROW + kp0 * 16, kl1 = kr1 * AT_KROW + kp1 * 16;
    const int vd = tid >> 3, vp = tid & 7;
    const bf16_t* vg = Vt + ((size_t)(b * NH + h) * 64 + vd) * SEQ + vp * 8;
    const int vl = AT_VOFF + vd * AT_VROW + vp * 16;
    u32x4 kreg0, kreg1 = (u32x4){0u, 0u, 0u, 0u}, vreg;
    kreg0 = *(const u32x4*)kg0; if (k2) kreg1 = *(const u32x4*)kg1; vreg = *(const u32x4*)vg;
    *(LAS u32x4*)(lds + kl0) = kreg0; if (k2) *(LAS u32x4*)(lds + kl1) = kreg1;
    *(LAS u32x2*)(lds + vl) = (u32x2){vreg.x, vreg.y}; *(LAS u32x2*)(lds + vl + 8) = (u32x2){vreg.z, vreg.w};
    __syncthreads();
    float m_run = -1e30f, l_run = 0.f; f32x16 o0, o1, cinit;
#pragma unroll
    for (int r = 0; r < 16; ++r) { o0[r] = 0.f; o1[r] = 0.f; cinit[r] = FIXED ? negB : 0.f; }
    for (int t = 0; t < NT_; ++t) {
        const bool pre = (t + 1 < NT_);
        if (pre) { kreg0 = *(const u32x4*)(kg0 + (size_t)(t + 1) * ks0); if (k2) kreg1 = *(const u32x4*)(kg1 + (size_t)(t + 1) * ks1); vreg = *(const u32x4*)(vg + (t + 1) * 64); }
        const int kv0 = t * 64;
        if (kv0 <= q0 + wid * 32 + 31) {
            const LAS unsigned char* kb = lds + (t & 1) * AT_KBUF + r32 * AT_KROW + hi * 16;
            const LAS unsigned char* vb = lds + AT_VOFF + (t & 1) * AT_VBUF + r32 * AT_VROW + hi * 8;
            f32x16 s0, s1;
            { bf16x8 kf[12];
#pragma unroll
              for (int s = 0; s < 6; ++s) { kf[2 * s] = *(const LAS bf16x8*)(kb + s * 32); kf[2 * s + 1] = *(const LAS bf16x8*)(kb + 32 * AT_KROW + s * 32); }
              asm volatile("s_waitcnt lgkmcnt(0)" ::: "memory"); __builtin_amdgcn_sched_barrier(0);
#pragma unroll
              for (int s = 0; s < 6; ++s) { s0 = __builtin_amdgcn_mfma_f32_32x32x16_bf16(kf[2 * s], qf[s], s == 0 ? cinit : s0, 0, 0, 0); s1 = __builtin_amdgcn_mfma_f32_32x32x16_bf16(kf[2 * s + 1], qf[s], s == 0 ? cinit : s1, 0, 0, 0); } }
            __builtin_amdgcn_sched_barrier(0);
            u32x2 vf[16];
#pragma unroll
            for (int s = 0; s < 4; ++s) { vf[4 * s] = *(const LAS u32x2*)(vb + s * 32); vf[4 * s + 1] = *(const LAS u32x2*)(vb + s * 32 + 16);
                vf[4 * s + 2] = *(const LAS u32x2*)(vb + 32 * AT_VROW + s * 32); vf[4 * s + 3] = *(const LAS u32x2*)(vb + 32 * AT_VROW + s * 32 + 16); }
            if (kv0 + 63 > q0 + wid * 32) {
#pragma unroll
                for (int r = 0; r < 16; ++r) { const int kv = kv0 + crow(r, hi); if (kv > qabs) s0[r] = -1e30f; if (kv + 32 > qabs) s1[r] = -1e30f; }
            }
            if (FIXED) {
                float ps = 0.f;
#pragma unroll
                for (int r = 0; r < 16; ++r) { s0[r] = __builtin_amdgcn_exp2f(s0[r]); s1[r] = __builtin_amdgcn_exp2f(s1[r]); ps += s0[r] + s1[r]; }
                l_run += ps;
            } else {
                float mx = fmaxf(s0[0], s1[0]);
#pragma unroll
                for (int r = 1; r < 16; ++r) mx = fmaxf(mx, fmaxf(s0[r], s1[r]));
                mx = fmaxf(mx, __shfl_xor(mx, 32));
                const float m_new = fmaxf(m_run, mx), alpha = __builtin_amdgcn_exp2f(m_run - m_new); m_run = m_new;
                float ps = 0.f;
#pragma unroll
                for (int r = 0; r < 16; ++r) { s0[r] = __builtin_amdgcn_exp2f(s0[r] - m_new); s1[r] = __builtin_amdgcn_exp2f(s1[r] - m_new); ps += s0[r] + s1[r]; }
                l_run = l_run * alpha + ps;
#pragma unroll
                for (int r = 0; r < 16; ++r) { o0[r] *= alpha; o1[r] *= alpha; }
            }
            bf16x8 pk[4];
#pragma unroll
            for (int s = 0; s < 4; ++s) { u32x4 w;
#pragma unroll
                for (int e = 0; e < 4; ++e) { const int r = 8 * (s & 1) + 2 * e; w[e] = (s < 2) ? cvtpk(s0[r], s0[r + 1]) : cvtpk(s1[r], s1[r + 1]); }
                pk[s] = __builtin_bit_cast(bf16x8, w); }
            asm volatile("s_waitcnt lgkmcnt(0)" ::: "memory"); __builtin_amdgcn_sched_barrier(0);
#pragma unroll
            for (int s = 0; s < 4; ++s) {
                { const u32x4 w = (u32x4){vf[4 * s].x, vf[4 * s].y, vf[4 * s + 1].x, vf[4 * s + 1].y}; o0 = __builtin_amdgcn_mfma_f32_32x32x16_bf16(__builtin_bit_cast(bf16x8, w), pk[s], o0, 0, 0, 0); }
                { const u32x4 w = (u32x4){vf[4 * s + 2].x, vf[4 * s + 2].y, vf[4 * s + 3].x, vf[4 * s + 3].y}; o1 = __builtin_amdgcn_mfma_f32_32x32x16_bf16(__builtin_bit_cast(bf16x8, w), pk[s], o1, 0, 0, 0); }
            }
        }
        if (pre) { const int bo = ((t + 1) & 1); *(LAS u32x4*)(lds + bo * AT_KBUF + kl0) = kreg0; if (k2) *(LAS u32x4*)(lds + bo * AT_KBUF + kl1) = kreg1;
            *(LAS u32x2*)(lds + bo * AT_VBUF + vl) = (u32x2){vreg.x, vreg.y}; *(LAS u32x2*)(lds + bo * AT_VBUF + vl + 8) = (u32x2){vreg.z, vreg.w}; }
        __syncthreads();
    }
    const float lt = l_run + __shfl_xor(l_run, 32), inv = 1.0f / lt;
    bf16_t* op = O + (rowbase + qabs) * DM + h * 64 + 4 * hi;
#pragma unroll
    for (int g = 0; g < 4; ++g) { u32x2 w; w.x = cvtpk(o0[4 * g] * inv, o0[4 * g + 1] * inv); w.y = cvtpk(o0[4 * g + 2] * inv, o0[4 * g + 3] * inv); *(u32x2*)(op + 8 * g) = w;
        u32x2 w2; w2.x = cvtpk(o1[4 * g] * inv, o1[4 * g + 1] * inv); w2.y = cvtpk(o1[4 * g + 2] * inv, o1[4 * g + 3] * inv); *(u32x2*)(op + 32 + 8 * g) = w2; }
}
__device__ __forceinline__ float wave_max(float v) {
#pragma unroll
    for (int o = 1; o < 64; o <<= 1) v = fmaxf(v, __shfl_xor(v, o));
    return v;
}
__device__ __forceinline__ void phase_attn(const Args& a, LAS unsigned char* lds, int tid_in, int j) {
    const int gx_ = opq_s(blockIdx.x) & 7;
    const bf16_t* Q = (const bf16_t*)(a.ws + voff(gx_, L_QRAW, 3072)); const bf16_t* Kf = (const bf16_t*)(a.ws + voff(gx_, L_KF, 2048)); const bf16_t* KR = (const bf16_t*)(a.ws + voff(gx_, L_KR, 64)); const bf16_t* Vt = (const bf16_t*)(a.ws + voff(gx_, L_VT, 2048)); bf16_t* O = (bf16_t*)(a.ws + voff(gx_, L_O, 2048));
    float B;
    { const int lane = opq_v(tid_in) & 63;
      const float gqn = wave_max(fabsf(a.in[I_QNOPEN][j * 64 + lane])), gkn = wave_max(fabsf(a.in[I_KNOPEN][lane]));
      const float gqr = wave_max(fabsf(a.in[I_QROPEN][j * 32 + (lane & 31)])), gkr = wave_max(fabsf(a.in[I_KROPEN][lane & 31]));
      B = sqrtf(64.f * gqn * gqn + 32.f * gqr * gqr) * sqrtf(64.f * gkn * gkn + 32.f * gkr * gkr) * QSCALE * 1.02f; }
    const bool fixed = (B <= 40.0f);
    const int bx = opq_s(blockIdx.x); const int vcu = (bx & 7) * 32 + (bx >> 3);
    for (int p = vcu * 8; p < vcu * 8 + 8; ++p) {
        const int bh = p >> 2, s = p & 3;
        if (fixed) { attn_unit<true>(lds, Q, Kf, KR, Vt, O, bh / NH, bh % NH, 7 - s, tid_in, -B); attn_unit<true>(lds, Q, Kf, KR, Vt, O, bh / NH, bh % NH, s, tid_in, -B); }
        else { attn_unit<false>(lds, Q, Kf, KR, Vt, O, bh / NH, bh % NH, 7 - s, tid_in, 0.f); attn_unit<false>(lds, Q, Kf, KR, Vt, O, bh / NH, bh % NH, s, tid_in, 0.f); }
    }
}

#define XB_TMO      128
#define XB_XCNT(j)  (256  + 64 * (j))
#define XB_XSUB(j)  (1280 + 64 * (j))
#define XB_XGEN(j)  (2304 + 64 * (j))
#define XB_TOP      3328
#define XB_TOPGEN   3392
#define XCD_BAR_WORDS 3456
#define XB_SPIN_CAP (1u << 18)

__device__ __forceinline__ unsigned xb_ld(unsigned* p)              { return __hip_atomic_load(p, __ATOMIC_RELAXED, __HIP_MEMORY_SCOPE_AGENT); }
__device__ __forceinline__ unsigned xb_add(unsigned* p, unsigned v) { return __hip_atomic_fetch_add(p, v, __ATOMIC_RELAXED, __HIP_MEMORY_SCOPE_AGENT); }
__device__ __forceinline__ unsigned xb_xcc_id() { return (unsigned)__builtin_amdgcn_s_getreg((3 << 11) | 20) & 0xFu; }
#define XB_SPIN(cond, bar) do { unsigned _sp = 0; while (cond) { __builtin_amdgcn_s_sleep(1); \
    if ((++_sp & 255u) == 0u) { if (xb_ld(&(bar)[XB_TMO])) break; if (_sp > XB_SPIN_CAP) { atomicAdd(&(bar)[XB_TMO], 1u); break; } } } } while (0)

#ifndef GB_SKIP_WB
#define GB_SKIP_WB 1
#endif
struct XcdBarrier {
    unsigned* bar; unsigned x; unsigned gsz;
    volatile LAS unsigned* st;
};

__device__ __forceinline__ XcdBarrier xcd_barrier_post(unsigned* bar, volatile LAS unsigned* st) {
    XcdBarrier b; b.bar = bar; b.x = xb_xcc_id(); b.st = st;
    if (threadIdx.x == 0) (void)xb_add(&bar[XB_XCNT(b.x)], 1u);
    return b;
}
__device__ __forceinline__ void xcd_barrier_complete(unsigned* bar, unsigned x, unsigned& nloc, unsigned& nx, unsigned G) {
    unsigned sum, cnt, mine, sp = 0u;
    for (;;) {
        sum = 0u; cnt = 0u; mine = 0u;
#pragma unroll
        for (unsigned j = 0; j < 16; ++j) { const unsigned c = xb_ld(&bar[XB_XCNT(j)]); sum += c; cnt += (c > 0u) ? 1u : 0u; mine = (j == x) ? c : mine; }
        if (sum == G) break;
        __builtin_amdgcn_s_sleep(1);
        if ((++sp & 255u) == 0u) { if (xb_ld(&bar[XB_TMO])) break; if (sp > XB_SPIN_CAP) { atomicAdd(&bar[XB_TMO], 1u); break; } }
    }
    nloc = mine > 0u ? mine : 1u; nx = cnt > 0u ? cnt : 1u;
}

__device__ __forceinline__ void xcd_barrier(const XcdBarrier& b, int tid_in) {
    asm volatile("s_waitcnt vmcnt(0)" ::: "memory");
    __syncthreads();
    if (tid_in == 0) {
        unsigned* bar = b.bar; asm volatile("" : "+s"(bar));
        __builtin_amdgcn_s_waitcnt(0);
        unsigned nloc = b.st[0], nx = b.st[1];
        if (nloc == 0u) { xcd_barrier_complete(bar, b.x, nloc, nx, b.gsz); b.st[0] = nloc; b.st[1] = nx; }
        const unsigned old = xb_add(&bar[XB_XSUB(b.x)], 1u);
        const unsigned gen = old / nloc;
        if (old + 1u == (gen + 1u) * nloc) {
            if (GB_SKIP_WB == 0 || nx > 1u) {
            __builtin_amdgcn_fence(__ATOMIC_RELEASE, "agent");
            asm volatile("s_waitcnt vmcnt(0)" ::: "memory"); }
            const unsigned og = xb_add(&bar[XB_TOP], 1u);
            const unsigned tg = og / nx;
            if (og + 1u == (tg + 1u) * nx) xb_add(&bar[XB_TOPGEN], 1u);
            else XB_SPIN(xb_ld(&bar[XB_TOPGEN]) == tg, bar);
            __builtin_amdgcn_fence(__ATOMIC_ACQUIRE, "agent");
            xb_add(&bar[XB_XGEN(b.x)], 1u);
            asm volatile("s_waitcnt vmcnt(0)" ::: "memory");
        } else {
            XB_SPIN(xb_ld(&bar[XB_XGEN(b.x)]) == gen, bar);
            __builtin_amdgcn_fence(__ATOMIC_ACQUIRE, "agent");
            asm volatile("s_waitcnt vmcnt(0)" ::: "memory");
        }
    }
    __syncthreads();
}

#ifndef PHMASK
#define PHMASK 0xFFFFFFFFu
#endif
#define EN(k) (((PHMASK) >> (k)) & 1u)
#ifndef REPMASK
#define REPMASK 0u
#endif
#define REP(k) (((REPMASK) >> (k)) & 1u)
constexpr int LDS_BYTES = 131072 + 256;
#if defined(__HIP_DEVICE_COMPILE__)
typedef const __attribute__((address_space(4))) Args* kargs_t;
#else
typedef const Args* kargs_t;
#endif
__device__ __forceinline__ kargs_t args_ptr() {
    unsigned long long v = (unsigned long long)__builtin_amdgcn_kernarg_segment_ptr(); asm volatile("" : "+s"(v)); return (kargs_t)v;
}
__global__ void __launch_bounds__(512, 2) yoco_fwd(Args a0) {
    extern __shared__ __attribute__((aligned(16))) unsigned char lds_raw[];
    LAS unsigned char* lds = (LAS unsigned char*)lds_raw;
    cg::grid_group grid = cg::this_grid();
    const int G = gridDim.x, bx = blockIdx.x;
    const int s_wid = __builtin_amdgcn_readfirstlane((int)threadIdx.x >> 6);
#define TIDV ((s_wid << 6) | lane_id_opq())
    if (threadIdx.x < 64) ((LAS unsigned*)(lds + 131072))[threadIdx.x] = 0u;
    __syncthreads();
    XcdBarrier xbar = xcd_barrier_post((unsigned*)(a0.ws + WS_BAR + (size_t)(bx & 7) * WS_BAR_GRP), (volatile LAS unsigned*)(lds + 131072)); xbar.gsz = 32u;
#define GRID_SYNC() xcd_barrier(xbar, TIDV)
#define PHASE_BEGIN(k) { for (int rep_ = 0; rep_ <= (int)REP(k); ++rep_) { if (rep_) GRID_SYNC(); const Args a = *args_ptr(); unsigned char* ws = a.ws; const int gx = opq_s(bx) & 7; (void)gx; bf16_t* xb = (bf16_t*)(ws + WS_XB); float* slots = (float*)(ws + WS_SLOT); float* slots2 = (float*)(ws + WS_SLOT2); (void)xb; (void)slots; (void)slots2;
#define PHASE_END   } GRID_SYNC(); }
#define PHASE_END_LAST(cond) } if (cond) GRID_SYNC(); }
    using namespace pg8;
#ifdef EXTRA_SYNCS
    for (int i_ = 0; i_ < EXTRA_SYNCS; ++i_) GRID_SYNC();
#endif
    PHASE_BEGIN(0) phase_setup(a, lds, TIDV); } grid.sync(); }
#pragma unroll 1
    for (int layer = 0; layer < 4; ++layer) {
        if (layer < 2) {
            PHASE_BEGIN(1) { Gemm g{xb, (const bf16_t*)(ws + WS_WIN) + (size_t)layer * DM * DM, DM, DM, DM, 0, 0}; Sched S; S.init(T, DM, 1, opq_s(G), opq_s(bx));
                EpiScaleBf16<1, false> E{(bf16_t*)(ws + voff(gx, L_AG, 48)), 0, RowScale{slots, 0, 8, 1.0f / DM}, nullptr}; gemm_phase<EpiScaleBf16<1, false>, true>(lds, g, S, E, TIDV); } PHASE_END
            PHASE_BEGIN(2) { Gemm g{(const bf16_t*)(ws + loff_(gx, L_AG)), (const bf16_t*)(ws + WS_BTP) + (size_t)layer * 64 * 256 * 256, 256, 384, 256, 512L * 384, 256L * 256}; Sched S; S.init_local(1, opq_s(bx));
                EpiSsmP E{(float*)(ws + loff_(gx, L_WST))}; gemm_phase<EpiSsmP, true>(lds, g, S, E, TIDV); } PHASE_END
            PHASE_BEGIN(3) phase_scan(a, layer, TIDV); PHASE_END
            PHASE_BEGIN(4) { Gemm g{(const bf16_t*)(ws + loff_(gx, L_AG)), (const bf16_t*)(ws + WS_BTY) + (size_t)layer * 64 * 256 * 384, 384, 384, 384, 512L * 384, 256L * 384}; Sched S; S.init_local(1, opq_s(bx));
                EpiSsmY E{(const bf16_t*)(ws + loff_(gx, L_AG)), a.in[I_SD] + layer * DM, (bf16_t*)(ws + loff_(gx, L_Z))}; gemm_phase<EpiSsmY, true>(lds, g, S, E, TIDV); } PHASE_END
            PHASE_BEGIN(5) { Gemm g{(const bf16_t*)(ws + voff(gx, L_Z, 2048)), (const bf16_t*)(ws + WS_WGLU) + (size_t)layer * 2 * DM * DM, DM, DM, DM, 0, 0}; Sched S; S.init(T, 2 * DM, 1, opq_s(G), opq_s(bx));
                EpiRes<true> E{a.out, xb, slots, false}; gemm_phase<EpiRes<true>, true>(lds, g, S, E, TIDV); } PHASE_END
        } else {
            const int j = layer - 2;
            if (j == 0) {
                PHASE_BEGIN(6) { Gemm g{xb, (const bf16_t*)(ws + WS_WQKVA), DM, DM, DM, 0, 0}; Sched S; S.init(T, 768, 1, opq_s(G), opq_s(bx));
                    EpiScaleBf16<0, true> E{(bf16_t*)(ws + voff(gx, L_QKVA, 1536)), 768, RowScale{slots, 0, 8, 1.0f / DM}, slots2}; gemm_phase<EpiScaleBf16<0, true>, true>(lds, g, S, E, TIDV); } PHASE_END
                PHASE_BEGIN(7) { phase_krope(a, TIDV);
                    { Gemm g{(const bf16_t*)(ws + voff(gx, L_QKVA, 1536)) + 384, (const bf16_t*)(ws + WS_WKVB), 256, 768, 256, 0, 0}; Sched S; S.init(T, 1024, 1, opq_s(G), opq_s(bx));
                      EpiHead E{(bf16_t*)(ws + voff(gx, L_KF, 2048)), RowScale{slots2, 12, 2, 1.0f / 256}, a.in[I_KNOPEN], nullptr, nullptr, nullptr, 1.0f, 1024, 64}; gemm_phase<EpiHead, true>(lds, g, S, E, TIDV); }
                    { Gemm g{(const bf16_t*)(ws + WS_WKVB) + (size_t)1024 * 256, (const bf16_t*)(ws + voff(gx, L_QKVA, 1536)) + 384, 256, 256, 768, 0, 0}; Sched S; S.init_local(2, opq_s(bx));
                      EpiVt E{(bf16_t*)(ws + voff(gx, L_VT, 2048)), slots2}; gemm_phase<EpiVt, true>(lds, g, S, E, TIDV); }
                    { Gemm g{(const bf16_t*)(ws + voff(gx, L_QKVA, 1536)), (const bf16_t*)(ws + WS_WQB), 384, 768, 384, 0, 0}; Sched S; S.init(T, 1536, 1, opq_s(G), opq_s(bx));
                      EpiHead E{(bf16_t*)(ws + voff(gx, L_QRAW, 3072)), RowScale{slots2, 0, 3, 1.0f / 384}, a.in[I_QNOPEN], a.in[I_QROPEN], (const float*)(ws + WS_ROPE), (const float*)(ws + WS_ROPE) + (size_t)T * 16, QSCALE, 1536, 96}; gemm_phase<EpiHead, true>(lds, g, S, E, TIDV); } } PHASE_END
            } else {
                PHASE_BEGIN(10) { Gemm g{xb, (const bf16_t*)(ws + WS_WQA3), DM, DM, DM, 0, 0}; Sched S; S.init(T, 512, 1, opq_s(G), opq_s(bx));
                    EpiScaleBf16<0, true> E{(bf16_t*)(ws + voff(gx, L_QKVA, 1024)), 512, RowScale{slots, 0, 8, 1.0f / DM}, slots2}; gemm_phase<EpiScaleBf16<0, true>, true>(lds, g, S, E, TIDV); } PHASE_END
                PHASE_BEGIN(11) { Gemm g{(const bf16_t*)(ws + voff(gx, L_QKVA, 1024)), (const bf16_t*)(ws + WS_WQB) + (size_t)1536 * 384, 384, 512, 384, 0, 0}; Sched S; S.init(T, 1536, 1, opq_s(G), opq_s(bx));
                    EpiHead E{(bf16_t*)(ws + voff(gx, L_QRAW, 3072)), RowScale{slots2, 0, 3, 1.0f / 384}, a.in[I_QNOPEN] + 64, a.in[I_QROPEN] + 32, (const float*)(ws + WS_ROPE), (const float*)(ws + WS_ROPE) + (size_t)T * 16, QSCALE, 1536, 96}; gemm_phase<EpiHead, true>(lds, g, S, E, TIDV); } PHASE_END
            }
            PHASE_BEGIN(13) phase_attn(a, lds, TIDV, j); PHASE_END
            PHASE_BEGIN(14) { Gemm g{(const bf16_t*)(ws + voff(gx, L_O, 2048)), (const bf16_t*)(ws + WS_WO) + (size_t)j * DM * DM, DM, DM, DM, 0, 0}; Sched S; S.init(T, DM, 1, opq_s(G), opq_s(bx));
                EpiRes<false> E{a.out, xb, slots, false}; gemm_phase<EpiRes<false>, true>(lds, g, S, E, TIDV); } PHASE_END
        }
        PHASE_BEGIN(15) { Gemm g{xb, (const bf16_t*)(ws + WS_WGU) + (size_t)layer * 2 * FF * DM, DM, DM, DM, 0, 0}; Sched S; S.init(T, 2 * FF, 1, opq_s(G), opq_s(bx));
            EpiSwiGLU E{(bf16_t*)(ws + voff(gx, L_FFA, 5632)), RowScale{slots, 0, 8, 1.0f / DM}}; gemm_phase<EpiSwiGLU, true>(lds, g, S, E, TIDV); } PHASE_END
        PHASE_BEGIN(16) { Gemm g{(const bf16_t*)(ws + voff(gx, L_FFA, 5632)), (const bf16_t*)(ws + WS_WDN) + (size_t)layer * DM * FF, FF, FF, FF, 0, 0}; Sched S; S.init(T, DM, 1, opq_s(G), opq_s(bx));
            EpiRes<false> E{a.out, xb, slots, layer == 3}; gemm_phase<EpiRes<false>, true>(lds, g, S, E, TIDV); } PHASE_END_LAST(layer < 3)
    }
}

extern "C" void kernel_launch(void* const* d_in, const int* in_sizes, int n_in, void* d_out, int out_size, void* d_ws, size_t ws_size, hipStream_t stream) {
    static int grid = 0;
    if (grid == 0) {
        if (n_in != N_IN || out_size != T * DM || ws_size < WS_END) { fprintf(stderr, "kernel_launch: unexpected shapes (n_in %d out %d ws %zu)\n", n_in, out_size, ws_size); grid = -1; return; }
        int dev = 0, cus = 0, per = 0;
        (void)hipGetDevice(&dev); (void)hipDeviceGetAttribute(&cus, hipDeviceAttributeMultiprocessorCount, dev);
        (void)hipFuncSetAttribute((const void*)yoco_fwd, hipFuncAttributeMaxDynamicSharedMemorySize, LDS_BYTES);
        (void)hipOccupancyMaxActiveBlocksPerMultiprocessor(&per, (const void*)yoco_fwd, 512, LDS_BYTES);
        if (per < 1) per = 1;
        grid = cus * per;
        if (grid != 256) { fprintf(stderr, "kernel_launch: this build needs a 256-workgroup grid (8 groups of 32), got %d; nothing launched\n", grid); grid = -1; return; }
        fprintf(stderr, "kernel_launch: grid %d (cus %d x %d)\n", grid, cus, per);
    }
    if (grid < 0) return;
    (void)hipMemsetAsync((unsigned char*)d_ws + WS_BAR, 0, WS_BAR_BYTES, stream);
    Args a{};
    for (int i = 0; i < N_IN; ++i) a.in[i] = (const float*)d_in[i];
    a.out = (float*)d_out; a.ws = (unsigned char*)d_ws; a.ph_lo = 0; a.ph_hi = 1000;
    void* args[] = {&a};
    hipError_t e = hipLaunchCooperativeKernel((const void*)yoco_fwd, dim3(grid), dim3(512), args, LDS_BYTES, stream);
    if (e != hipSuccess) fprintf(stderr, "kernel_launch: cooperative launch failed: %s (grid %d)\n", hipGetErrorString(e), grid);
}
```

```cpp
#include <hip/hip_runtime.h>
#include <hip/hip_cooperative_groups.h>
#include <cstdio>
#include <cstdint>
namespace cg = cooperative_groups;

#define LAS __attribute__((address_space(3)))
typedef unsigned short bf16_t;
typedef short bf16x8 __attribute__((ext_vector_type(8)));
typedef float f32x4 __attribute__((ext_vector_type(4)));
typedef float f32x16 __attribute__((ext_vector_type(16)));
typedef unsigned u32x4 __attribute__((ext_vector_type(4)));
typedef unsigned u32x2 __attribute__((ext_vector_type(2)));
typedef float f32x2_t __attribute__((ext_vector_type(2)));
typedef __bf16 bf16x2_t __attribute__((ext_vector_type(2)));

constexpr int T = 65536, DM = 1024, SEQ = 2048, NB = 32, FF = 2816, NH = 16;
constexpr float EPS = 1e-6f;
constexpr float QSCALE = 0.14724444f;

constexpr size_t MiB = 1u << 20;
constexpr size_t WS_WIN = 0, WS_WGLU = 4 * MiB, WS_WGU = 12 * MiB, WS_WDN = 56 * MiB, WS_WQKVA = 78 * MiB, WS_WQA3 = 80 * MiB,
                 WS_WQB = 81 * MiB, WS_WKVB = 84 * MiB, WS_WO = 85 * MiB, WS_BTY = 90 * MiB, WS_BTP = 114 * MiB, WS_AC = 130 * MiB,
                 WS_ROPE = 131 * MiB, WS_SLOT = 139 * MiB, WS_SLOT2 = 147 * MiB, WS_XB = 155 * MiB,
                 WS_KF = 283 * MiB, WS_VT = 475 * MiB, WS_R = 603 * MiB, WS_END = 1024 * MiB;
constexpr size_t WS_BAR = 130 * MiB + 512 * 1024, WS_BAR_GRP = 16384, WS_BAR_BYTES = 8 * WS_BAR_GRP;
constexpr size_t SLICE0 = 283 * MiB, SLICE = (741 * MiB) / 8, GTOK = 8192;
constexpr size_t L_KF = 0, L_KR = 16 * MiB, L_AG = 0, L_VT = 24 * MiB, L_WST = 24 * MiB, L_R = 40 * MiB, L_FFA = L_R, L_Z = L_R, L_QRAW = L_R, L_O = L_R + 24 * MiB + 512 * 1024, L_QKVA = L_R + 37 * MiB + 512 * 1024;
__host__ __device__ __forceinline__ size_t voff(int gx, size_t loff, size_t rowbytes) { return SLICE0 + loff + (size_t)gx * (SLICE - GTOK * rowbytes); }
__host__ __device__ __forceinline__ size_t loff_(int gx, size_t loff) { return SLICE0 + loff + (size_t)gx * SLICE; }

enum { I_X = 0, I_POS, I_MIXN, I_FFNN, I_WGU, I_WDN, I_SWIN, I_LRE, I_LIM, I_LSTEP, I_BRE, I_BIM, I_CRE, I_CIM, I_SD, I_SGLU,
       I_KVINN, I_WKVA, I_KVAN, I_WKVB, I_KNOPEN, I_KROPEN, I_WQA, I_QAN, I_WQB, I_QNOPEN, I_QROPEN, I_WO, N_IN };

__device__ __forceinline__ int opq_v(int v) { asm volatile("" : "+v"(v)); return v; }
__device__ __forceinline__ int opq_s(int v) { asm volatile("" : "+s"(v)); return v; }
__device__ __forceinline__ int lane_id_opq() { unsigned z = 0u; asm volatile("" : "+v"(z)); return (int)__builtin_amdgcn_mbcnt_hi(~0u, __builtin_amdgcn_mbcnt_lo(~0u, z)); }
__device__ __forceinline__ unsigned cvtpk(float lo, float hi) { f32x2_t v = {lo, hi}; bf16x2_t b = __builtin_convertvector(v, bf16x2_t); return __builtin_bit_cast(unsigned, b); }
__device__ __forceinline__ float bflo(unsigned w) { return __uint_as_float(w << 16); }
__device__ __forceinline__ float bfhi(unsigned w) { return __uint_as_float(w & 0xffff0000u); }
__device__ __forceinline__ float sigmoidf_(float x) { return __builtin_amdgcn_rcpf(1.0f + __builtin_amdgcn_exp2f(-1.4426950408889634f * x)); }
__device__ __forceinline__ float gelu_tanh(float x) { const float u = 1.5957691216057308f * (x + 0.044715f * x * x * x); return x * sigmoidf_(u); }

namespace pg8 {
constexpr int BM = 256, BK = 64, HALF = 128, HTB = HALF * BK * 2, STAGE_BYTES = 8 * HTB, NXCD = 8, WGM = 8;
__host__ __device__ __forceinline__ int lds_byte(int r, int c) { const int st = (r >> 4) * 2 + (c >> 5), rr = r & 15, cc = c & 31, ob = rr * 64 + cc * 2; return st * 1024 + (ob ^ (((ob >> 9) & 1) << 5)); }
__host__ __device__ __forceinline__ void stage_rc(int b, int& R, int& C) { const int st = b / 1024, sb = b % 1024, swz = sb ^ (((sb >> 9) & 1) << 5); R = (st >> 1) * 16 + swz / 64; C = (st & 1) * 32 + (swz % 64) / 2; }
__host__ __device__ __forceinline__ int perm32(int rho) { const int n = rho >> 4, i = rho & 15; return 8 * (i >> 2) + 4 * n + (i & 3); }

struct Unit { int pm, pn, pg; };
struct Gemm { const bf16_t* A; const bf16_t* Bt; int K, lda, ldb; long gsA, gsB; };

struct Sched {
    int nM, nN, nwg, nG, G, c, mode;
    __device__ void init(int M, int N, int nG_, int G_, int c_) { nM = M / BM; nN = N / BM; nwg = nM * nN; nG = nG_; G = G_; c = c_; mode = 0; }
    __device__ void init_local(int mode_, int c_) { nM = nN = nwg = nG = 1; G = 256; c = c_; mode = mode_; }
    __device__ bool next(int i, Unit& u) const {
        if (mode == 1) { if (i >= 4) return false; const int j = (c >> 3) + 32 * i; u.pg = j >> 1; u.pm = j & 1; u.pn = 0; return true; }
        if (mode == 2) { if (i >= 4) return false; const int j = (c >> 3) + 32 * i; u.pg = 0; u.pm = j & 3; u.pn = 32 * (c & 7) + (j >> 2); return true; }
        const long L = (long)i * G + c; if (L >= (long)nwg * nG) return false;
        u.pg = (int)(L / nwg); int wgid = (int)(L % nwg);
        { const int q = nwg / NXCD, r = nwg % NXCD, xcd = wgid % NXCD, off = wgid / NXCD; wgid = (xcd < r ? xcd * (q + 1) : r * (q + 1) + (xcd - r) * q) + off; }
        const int nig = WGM * nN, gid = wgid / nig, fm = gid * WGM, gsz = (nM - fm) < WGM ? (nM - fm) : WGM;
        u.pm = fm + ((wgid % nig) % gsz); u.pn = (wgid % nig) / gsz; return true;
    }
};

template <class Epi, bool ALIGN_EPI>
__device__ __forceinline__ void gemm_phase(LAS unsigned char* lds, const Gemm g, const Sched& S, const Epi& E, int tid_in) {
    int tid_ = tid_in; asm volatile("" : "+v"(tid_));
    const int tid = tid_, wid = __builtin_amdgcn_readfirstlane(tid >> 6), lane = tid & 63, wr = wid >> 2, wc = wid & 3, fr = lane & 15, fq = lane >> 4;
    const int K = g.K, nt = K / BK;
    unsigned voffA[2], voffB[2];
#pragma unroll
    for (int i = 0; i < 2; ++i) { int R, C; stage_rc(tid * 16 + i * 8192, R, C); const int Rb = (R & ~31) + perm32(R & 31);
        voffA[i] = (unsigned)(R * g.lda + C) * 2u; voffB[i] = (unsigned)(Rb * g.ldb + C) * 2u; }
    const size_t kstep = (size_t)(BK * 2);
    const size_t hsA = (size_t)HALF * g.lda * 2, hsB = (size_t)HALF * g.ldb * 2;
    const size_t tsA = 2 * hsA, tsB = 2 * hsB;
    const unsigned ldsw = (unsigned)wid * 1024u;
    const int aoff = lds_byte(wr * 64 + fr, fq * 8), boff = lds_byte(wc * 32 + fr, fq * 8);
#define PG8_SA(b, h) (((b) * 2 + (h)) * HTB)
#define PG8_SB(b, h) ((4 + (b) * 2 + (h)) * HTB)
#define PG8_STAGE(bufoff, gbase, voff) do { _Pragma("unroll") for (int _i = 0; _i < 2; ++_i) \
        __builtin_amdgcn_global_load_lds((const unsigned*)((const char*)(gbase) + (voff)[_i]), (LAS unsigned*)(lds + (bufoff) + ldsw + _i * 8192), 16, 0, 0); } while (0)
#define PG8_LDA(dst, b, h) do { _Pragma("unroll") for (int m = 0; m < 4; ++m) _Pragma("unroll") for (int k = 0; k < 2; ++k) dst[m][k] = *(const LAS bf16x8*)(lds + PG8_SA(b, h) + aoff + m * 2048 + k * 1024); } while (0)
#define PG8_LDB(dst, b, h) do { _Pragma("unroll") for (int n = 0; n < 2; ++n) _Pragma("unroll") for (int k = 0; k < 2; ++k) dst[n][k] = *(const LAS bf16x8*)(lds + PG8_SB(b, h) + boff + n * 2048 + k * 1024); } while (0)
#define PG8_MMA(ai, bj, At, Bt) do { __builtin_amdgcn_s_setprio(1); _Pragma("unroll") for (int m = 0; m < 4; ++m) _Pragma("unroll") for (int n = 0; n < 2; ++n) _Pragma("unroll") for (int k = 0; k < 2; ++k) \
        acc[ai][bj][m][n] = __builtin_amdgcn_mfma_f32_16x16x32_bf16(Bt[n][k], At[m][k], acc[ai][bj][m][n], 0, 0, 0); __builtin_amdgcn_s_setprio(0); } while (0)
#define PG8_WAIT_V(n) asm volatile("s_waitcnt vmcnt(" #n ")" ::: "memory")
#define PG8_WAIT_L(n) asm volatile("s_waitcnt lgkmcnt(" #n ")" ::: "memory")
#define PG8_BAR __builtin_amdgcn_s_barrier()
#define PG8_SCHED __builtin_amdgcn_sched_barrier(0)
    Unit cur, nxt; int ui = 0;
    if (!S.next(0, cur)) return;
    f32x4 acc[2][2][4][2];
#pragma unroll
    for (int a = 0; a < 2; ++a)
#pragma unroll
        for (int b = 0; b < 2; ++b)
#pragma unroll
            for (int m = 0; m < 4; ++m)
#pragma unroll
                for (int n = 0; n < 2; ++n) acc[a][b][m][n] = (f32x4){0.f, 0.f, 0.f, 0.f};
    bf16x8 At[4][2], B0[2][2], B1[2][2];
    const char* cA = (const char*)(g.A + (size_t)cur.pg * g.gsA) + (size_t)cur.pm * tsA;
    const char* cB = (const char*)(g.Bt + (size_t)cur.pg * g.gsB) + (size_t)cur.pn * tsB;
    PG8_STAGE(PG8_SB(0, 0), cB, voffB); PG8_STAGE(PG8_SB(0, 1), cB + hsB, voffB); PG8_STAGE(PG8_SA(0, 0), cA, voffA); PG8_STAGE(PG8_SA(0, 1), cA + hsA, voffA);
    if (wr == 1) PG8_BAR;
    PG8_WAIT_V(2); PG8_BAR;
    PG8_STAGE(PG8_SB(1, 0), cB + kstep, voffB); PG8_STAGE(PG8_SA(1, 0), cA + kstep, voffA); PG8_STAGE(PG8_SB(1, 1), cB + hsB + kstep, voffB);
    PG8_WAIT_V(6); PG8_BAR;
    for (;;) {
        const bool has_next = S.next(ui + 1, nxt);
        const char* nA = has_next ? (const char*)(g.A + (size_t)nxt.pg * g.gsA) + (size_t)nxt.pm * tsA : cA;
        const char* nB = has_next ? (const char*)(g.Bt + (size_t)nxt.pg * g.gsB) + (size_t)nxt.pn * tsB : cB;
        for (int t = 0; t < nt; t += 2) {
            const bool last = (t == nt - 2);
            const char* a1 = cA + (size_t)(t + 1) * kstep;
            const char* a2 = last ? nA : cA + (size_t)(t + 2) * kstep; const char* b2 = last ? nB : cB + (size_t)(t + 2) * kstep;
            const char* a3 = a2 + kstep; const char* b3 = b2 + kstep;
            PG8_LDB(B0, 0, 0); PG8_LDB(B1, 0, 1); PG8_SCHED; PG8_LDA(At, 0, 0); PG8_STAGE(PG8_SA(1, 1), a1 + hsA, voffA);
            PG8_WAIT_V(8); PG8_WAIT_L(0); PG8_BAR; PG8_MMA(0, 0, At, B0); PG8_MMA(0, 1, At, B1); PG8_BAR; PG8_SCHED;
            PG8_LDA(At, 0, 1); PG8_STAGE(PG8_SB(0, 0), b2, voffB); PG8_STAGE(PG8_SB(0, 1), b2 + hsB, voffB); PG8_STAGE(PG8_SA(0, 0), a2, voffA);
            PG8_WAIT_V(8); PG8_WAIT_L(0); PG8_BAR; PG8_MMA(1, 0, At, B0); PG8_MMA(1, 1, At, B1); PG8_BAR; PG8_SCHED;
            PG8_LDB(B0, 1, 0); PG8_LDB(B1, 1, 1); PG8_SCHED; PG8_LDA(At, 1, 0); PG8_STAGE(PG8_SA(0, 1), a2 + hsA, voffA);
            PG8_WAIT_V(8); PG8_WAIT_L(0); PG8_BAR; PG8_MMA(0, 0, At, B0); PG8_MMA(0, 1, At, B1); PG8_BAR; PG8_SCHED;
            PG8_LDA(At, 1, 1); PG8_STAGE(PG8_SB(1, 0), b3, voffB); PG8_STAGE(PG8_SB(1, 1), b3 + hsB, voffB); PG8_STAGE(PG8_SA(1, 0), a3, voffA);
            PG8_WAIT_V(8); PG8_WAIT_L(0); PG8_BAR; PG8_MMA(1, 0, At, B0); PG8_MMA(1, 1, At, B1); PG8_BAR; PG8_SCHED;
        }
        if constexpr (ALIGN_EPI) { if (wr == 0) PG8_BAR; }
        E(acc, cur, wr, wc, fr, fq);
        if (!has_next) break;
#pragma unroll
        for (int a = 0; a < 2; ++a)
#pragma unroll
            for (int b = 0; b < 2; ++b)
#pragma unroll
                for (int m = 0; m < 4; ++m)
#pragma unroll
                    for (int n = 0; n < 2; ++n) acc[a][b][m][n] = (f32x4){0.f, 0.f, 0.f, 0.f};
        cur = nxt; cA = nA; cB = nB; ++ui;
        if constexpr (ALIGN_EPI) { if (wr == 1) PG8_BAR; }
    }
    PG8_WAIT_V(0);
    if constexpr (!ALIGN_EPI) { if (wr == 0) PG8_BAR; }
    PG8_BAR;
#undef PG8_SA
#undef PG8_SB
#undef PG8_STAGE
#undef PG8_LDA
#undef PG8_LDB
#undef PG8_MMA
#undef PG8_WAIT_V
#undef PG8_WAIT_L
#undef PG8_BAR
#undef PG8_SCHED
}

struct RowScale {
    const float* slots; int s0, npf; float inv_n;
    __device__ __forceinline__ float get(int row, int fq) const {
        const float* p = slots + (size_t)row * 32 + s0 + fq * npf; float s = 0.f;
        for (int i = 0; i < npf; ++i) s += p[i];
        s += __shfl_xor(s, 16); s += __shfl_xor(s, 32);
        return rsqrtf(s * inv_n + EPS);
    }
};
__device__ __forceinline__ float ssq8(const f32x4& a, const f32x4& b) { return (a[0] * a[0] + a[1] * a[1]) + (a[2] * a[2] + a[3] * a[3]) + (b[0] * b[0] + b[1] * b[1]) + (b[2] * b[2] + b[3] * b[3]); }
__device__ __forceinline__ u32x4 pack8(const f32x4& a, const f32x4& b) { u32x4 w; w.x = cvtpk(a[0], a[1]); w.y = cvtpk(a[2], a[3]); w.z = cvtpk(b[0], b[1]); w.w = cvtpk(b[2], b[3]); return w; }

template <int MODE, bool SSQ> struct EpiScaleBf16 {
    bf16_t* O; int ldc; RowScale rs; float* ssq;
    __device__ __forceinline__ void operator()(const f32x4 (&acc)[2][2][4][2], const Unit& u, int wr, int wc, int fr, int fq) const {
        { const int l_ = lane_id_opq(); fr = l_ & 15; fq = l_ >> 4; }
        const int row0 = u.pm * BM + wr * 64 + fr, colb = u.pn * BM + wc * 32 + 8 * fq;
#pragma unroll
        for (int ai = 0; ai < 2; ++ai)
#pragma unroll
            for (int m = 0; m < 4; ++m) { const int row = row0 + ai * HALF + m * 16; const float r = rs.get(row, fq);
#pragma unroll
                for (int bj = 0; bj < 2; ++bj) { const int col = colb + bj * HALF; const f32x4 v0 = acc[ai][bj][m][0] * r, v1 = acc[ai][bj][m][1] * r;
                    bf16_t* p = (MODE == 0) ? O + (size_t)row * ldc + col : O + ((size_t)(col >> 4) * 512 + (row >> 4)) * 384 + (row & 15) * 16 + (col & 15);
                    *(u32x4*)p = pack8(v0, v1);
                    if (SSQ) { float s = ssq8(v0, v1); s += __shfl_xor(s, 16); s += __shfl_xor(s, 32); if (fq == 0) ssq[(size_t)row * 32 + (u.pn * 2 + bj) * 4 + wc] = s; } }
                asm volatile("" ::: "memory"); }
    }
};
template <bool GLU> struct EpiRes {
    float* xout; bf16_t* xb; float* ssq; bool wf32;
    __device__ __forceinline__ void operator()(const f32x4 (&acc)[2][2][4][2], const Unit& u, int wr, int wc, int fr, int fq) const {
        { const int l_ = lane_id_opq(); fr = l_ & 15; fq = l_ >> 4; }
        const int row0 = u.pm * BM + wr * 64 + fr;
#pragma unroll
        for (int ai = 0; ai < 2; ++ai)
#pragma unroll
            for (int m = 0; m < 4; ++m) { const int row = row0 + ai * HALF + m * 16;
#pragma unroll
                for (int bj = 0; bj < (GLU ? 1 : 2); ++bj) { f32x4 v0, v1; int col, slot;
                    if (GLU) { col = u.pn * HALF + wc * 32 + 8 * fq; slot = u.pn * 4 + wc;
#pragma unroll
                        for (int e = 0; e < 4; ++e) { v0[e] = acc[ai][0][m][0][e] * sigmoidf_(acc[ai][1][m][0][e]); v1[e] = acc[ai][0][m][1][e] * sigmoidf_(acc[ai][1][m][1][e]); }
                    } else { col = u.pn * BM + bj * HALF + wc * 32 + 8 * fq; slot = (u.pn * 2 + bj) * 4 + wc; v0 = acc[ai][bj][m][0]; v1 = acc[ai][bj][m][1]; }
                    const size_t p = (size_t)row * DM + col; const u32x4 xw = *(const u32x4*)(xb + p);
                    const f32x4 x0 = (f32x4){bflo(xw.x), bfhi(xw.x), bflo(xw.y), bfhi(xw.y)} + v0, x1 = (f32x4){bflo(xw.z), bfhi(xw.z), bflo(xw.w), bfhi(xw.w)} + v1;
                    if (wf32) { *(f32x4*)(xout + p) = x0; *(f32x4*)(xout + p + 4) = x1; }
                    *(u32x4*)(xb + p) = pack8(x0, x1);
                    float s = ssq8(x0, x1); s += __shfl_xor(s, 16); s += __shfl_xor(s, 32); if (fq == 0) ssq[(size_t)row * 32 + slot] = s; }
                asm volatile("" ::: "memory"); }
    }
};
struct EpiSwiGLU {
    bf16_t* O; RowScale rs;
    __device__ __forceinline__ void operator()(const f32x4 (&acc)[2][2][4][2], const Unit& u, int wr, int wc, int fr, int fq) const {
        { const int l_ = lane_id_opq(); fr = l_ & 15; fq = l_ >> 4; }
        const int row0 = u.pm * BM + wr * 64 + fr, col = u.pn * HALF + wc * 32 + 8 * fq;
#pragma unroll
        for (int ai = 0; ai < 2; ++ai)
#pragma unroll
            for (int m = 0; m < 4; ++m) { const int row = row0 + ai * HALF + m * 16; const float r = rs.get(row, fq); f32x4 v0, v1;
#pragma unroll
                for (int e = 0; e < 4; ++e) { const float g0 = acc[ai][0][m][0][e] * r, g1 = acc[ai][0][m][1][e] * r;
                    v0[e] = g0 * sigmoidf_(g0) * (acc[ai][1][m][0][e] * r); v1[e] = g1 * sigmoidf_(g1) * (acc[ai][1][m][1][e] * r); }
                *(u32x4*)(O + (size_t)row * FF + col) = pack8(v0, v1); asm volatile("" ::: "memory"); }
    }
};
struct EpiSsmP {
    float* W;
    __device__ __forceinline__ void operator()(const f32x4 (&acc)[2][2][4][2], const Unit& u, int wr, int wc, int fr, int fq) const {
        { const int l_ = lane_id_opq(); fr = l_ & 15; fq = l_ >> 4; }
        const int row0 = u.pm * BM + wr * 64 + fr;
#pragma unroll
        for (int ai = 0; ai < 2; ++ai)
#pragma unroll
            for (int m = 0; m < 4; ++m) { const int row = row0 + ai * HALF + m * 16; float* p = W + ((size_t)u.pg * 512 + row) * 128 + wc * 32 + 8 * fq;
                *(f32x4*)p = acc[ai][0][m][0]; *(f32x4*)(p + 4) = acc[ai][0][m][1]; }
    }
};
struct EpiSsmY {
    const bf16_t* Ag; const float* dskip; bf16_t* z;
    __device__ __forceinline__ void operator()(const f32x4 (&acc)[2][2][4][2], const Unit& u, int wr, int wc, int fr, int fq) const {
        { const int l_ = lane_id_opq(); fr = l_ & 15; fq = l_ >> 4; }
        const int row0 = u.pm * BM + wr * 64 + fr, k0 = (fq & 1) * 8;
#pragma unroll
        for (int ai = 0; ai < 2; ++ai)
#pragma unroll
            for (int m = 0; m < 4; ++m) { const int row = row0 + ai * HALF + m * 16;
#pragma unroll
                for (int bj = 0; bj < 2; ++bj) { const int col = bj * HALF + wc * 32 + 8 * fq, t = col >> 4;
                    const u32x4 uw = *(const u32x4*)(Ag + ((size_t)u.pg * 512 + row) * 384 + col);
                    const f32x4 d0 = *(const f32x4*)(dskip + u.pg * 16 + k0), d1 = *(const f32x4*)(dskip + u.pg * 16 + k0 + 4);
                    f32x4 y0 = acc[ai][bj][m][0], y1 = acc[ai][bj][m][1];
                    y0[0] += d0[0] * bflo(uw.x); y0[1] += d0[1] * bfhi(uw.x); y0[2] += d0[2] * bflo(uw.y); y0[3] += d0[3] * bfhi(uw.y);
                    y1[0] += d1[0] * bflo(uw.z); y1[1] += d1[1] * bfhi(uw.z); y1[2] += d1[2] * bflo(uw.w); y1[3] += d1[3] * bfhi(uw.w);
#pragma unroll
                    for (int e = 0; e < 4; ++e) { y0[e] = gelu_tanh(y0[e]); y1[e] = gelu_tanh(y1[e]); }
                    *(u32x4*)(z + ((size_t)row * 16 + t) * DM + u.pg * 16 + k0) = pack8(y0, y1); asm volatile("" ::: "memory"); } }
    }
};
struct EpiHead {
    bf16_t* O; RowScale rs; const float* gn; const float* gr; const float* rc; const float* rsn; float osc; int pitch, hs;
    __device__ __forceinline__ void operator()(const f32x4 (&acc)[2][2][4][2], const Unit& u, int wr, int wc, int fr, int fq) const {
        { const int l_ = lane_id_opq(); fr = l_ & 15; fq = l_ >> 4; }
        const int row0 = u.pm * BM + wr * 64 + fr;
        if (u.pn < 4) { const int h = 4 * u.pn + wc;
#pragma unroll
            for (int ai = 0; ai < 2; ++ai)
#pragma unroll
                for (int m = 0; m < 4; ++m) { const int row = row0 + ai * HALF + m * 16; const float r = rs.get(row, fq);
                    const f32x4 a0 = acc[ai][0][m][0] * r, a1 = acc[ai][0][m][1] * r, b0 = acc[ai][1][m][0] * r, b1 = acc[ai][1][m][1] * r;
                    float s = ssq8(a0, a1) + ssq8(b0, b1); s += __shfl_xor(s, 16); s += __shfl_xor(s, 32);
                    const float rh = rsqrtf(s * (1.0f / 64) + EPS) * osc;
                    bf16_t* p = O + (size_t)row * pitch + h * hs + 8 * fq;
                    { const f32x4 g0 = *(const f32x4*)(gn + 8 * fq), g1 = *(const f32x4*)(gn + 8 * fq + 4); *(u32x4*)p = pack8(a0 * g0 * rh, a1 * g1 * rh); }
                    { const f32x4 g0 = *(const f32x4*)(gn + 32 + 8 * fq), g1 = *(const f32x4*)(gn + 32 + 8 * fq + 4); *(u32x4*)(p + 32) = pack8(b0 * g0 * rh, b1 * g1 * rh); }
                    asm volatile("" ::: "memory"); }
        } else { const int h = 8 * (u.pn - 4) + 2 * wc + (fq >> 1), i0 = (fq & 1) * 8;
#pragma unroll
            for (int ai = 0; ai < 2; ++ai)
#pragma unroll
                for (int m = 0; m < 4; ++m) { const int row = row0 + ai * HALF + m * 16; const float r = rs.get(row, fq);
                    f32x4 x1a = acc[ai][0][m][0] * r, x1b = acc[ai][0][m][1] * r, x2a = acc[ai][1][m][0] * r, x2b = acc[ai][1][m][1] * r;
                    float s = ssq8(x1a, x1b) + ssq8(x2a, x2b); s += __shfl_xor(s, 16);
                    const float rh = rsqrtf(s * (1.0f / 32) + EPS);
                    x1a = x1a * *(const f32x4*)(gr + i0) * rh; x1b = x1b * *(const f32x4*)(gr + i0 + 4) * rh; x2a = x2a * *(const f32x4*)(gr + 16 + i0) * rh; x2b = x2b * *(const f32x4*)(gr + 16 + i0 + 4) * rh;
                    const f32x4 ca = *(const f32x4*)(rc + (size_t)row * 16 + i0) * osc, cb = *(const f32x4*)(rc + (size_t)row * 16 + i0 + 4) * osc, sa = *(const f32x4*)(rsn + (size_t)row * 16 + i0) * osc, sb = *(const f32x4*)(rsn + (size_t)row * 16 + i0 + 4) * osc;
                    bf16_t* p = O + (size_t)row * pitch + h * hs + 64 + i0;
                    *(u32x4*)p = pack8(x1a * ca - x2a * sa, x1b * cb - x2b * sb);
                    *(u32x4*)(p + 16) = pack8(x1a * sa + x2a * ca, x1b * sb + x2b * cb);
                    asm volatile("" ::: "memory"); }
        }
    }
};
struct EpiVt {
    bf16_t* Vt; const float* slots2;
    __device__ __forceinline__ void operator()(const f32x4 (&acc)[2][2][4][2], const Unit& u, int wr, int wc, int fr, int fq) const {
        { const int l_ = lane_id_opq(); fr = l_ & 15; fq = l_ >> 4; }
        const int row0 = u.pm * BM + wr * 64 + fr;
#pragma unroll
        for (int bj = 0; bj < 2; ++bj) { const int tok0 = u.pn * BM + bj * HALF + wc * 32 + 8 * fq, b = tok0 >> 11, l = tok0 & 2047;
            float rt[8];
#pragma unroll
            for (int e = 0; e < 8; ++e) { const float* p = slots2 + (size_t)(tok0 + e) * 32 + 12; const f32x4 a = *(const f32x4*)p, b2 = *(const f32x4*)(p + 4);
                rt[e] = rsqrtf(((a[0] + a[1]) + (a[2] + a[3]) + (b2[0] + b2[1]) + (b2[2] + b2[3])) * (1.0f / 256) + EPS);
                if ((e & 1) == 1) asm volatile("" ::: "memory"); }
#pragma unroll
            for (int ai = 0; ai < 2; ++ai)
#pragma unroll
                for (int m = 0; m < 4; ++m) { const int row = row0 + ai * HALF + m * 16;
                    f32x4 v0 = acc[ai][bj][m][0], v1 = acc[ai][bj][m][1];
#pragma unroll
                    for (int e = 0; e < 4; ++e) { v0[e] *= rt[e]; v1[e] *= rt[4 + e]; }
                    *(u32x4*)(Vt + ((size_t)(b * 1024 + row)) * SEQ + l) = pack8(v0, v1); }
            asm volatile("" ::: "memory"); }
    }
};
}

struct Args { const float* in[N_IN]; float* out; unsigned char* ws; int ph_lo, ph_hi; };

__device__ __forceinline__ void sincos_rev(double rev, float& sn, float& cs) {
    const double fr = rev - rint(rev); const double q = rint(4.0 * fr); const double y = fr - 0.25 * q; const double x = 6.283185307179586 * y, x2 = x * x;
    const double s = x * (1.0 + x2 * (-1.0 / 6 + x2 * (1.0 / 120 + x2 * (-1.0 / 5040 + x2 * (1.0 / 362880 + x2 * (-1.0 / 39916800 + x2 * (1.0 / 6227020800.0)))))));
    const double c = 1.0 + x2 * (-0.5 + x2 * (1.0 / 24 + x2 * (-1.0 / 720 + x2 * (1.0 / 40320 + x2 * (-1.0 / 3628800 + x2 * (1.0 / 479001600.0 + x2 * (-1.0 / 87178291200.0)))))));
    const int qi = ((int)q) & 3;
    const double ss = (qi == 0) ? s : (qi == 1) ? c : (qi == 2) ? -s : -c;
    const double cc = (qi == 0) ? c : (qi == 1) ? -s : (qi == 2) ? -c : s;
    sn = (float)ss; cs = (float)cc;
}

__device__ __forceinline__ void tr_item(const float* W, int K, int N, const float* gain, bf16_t* dst, int ldk, int mode, int H, int drow0, LAS float* scr, int item, int lane) {
    const int nblk = N / 32, kb = item / nblk, nb = item % nblk, k0 = 64 * kb, n0 = 32 * nb;
    { float v[32];
#pragma unroll
      for (int i = 0; i < 32; ++i) { const int kk = 2 * i + (lane >> 5); v[i] = W[(size_t)(k0 + kk) * N + n0 + (lane & 31)]; }
      if (gain) {
#pragma unroll
          for (int i = 0; i < 32; ++i) v[i] *= gain[k0 + 2 * i + (lane >> 5)]; }
#pragma unroll
      for (int i = 0; i < 32; ++i) scr[(2 * i + (lane >> 5)) * 33 + (lane & 31)] = v[i]; }
    asm volatile("s_waitcnt lgkmcnt(0)" ::: "memory");
    int drow, extra16 = 0;
    if (mode == 0) drow = drow0 + n0;
    else if (mode == 1) { const int half = n0 / H, j = n0 % H; drow = drow0 + (j / 128) * 256 + half * 128 + (j % 128); }
    else if (mode == 2) { const int h = n0 / 128, part = (n0 % 128) / 32;
        drow = (part < 2) ? (h / 4) * 256 + part * 128 + (h % 4) * 32 : 1024 + h * 64 + (part - 2) * 32; }
    else { const int h = n0 / 96, part = (n0 % 96) / 32;
        if (part < 2) drow = (h / 4) * 256 + part * 128 + (h % 4) * 32; else { drow = 1024 + (h / 8) * 256 + ((h % 8) / 2) * 32 + (h % 2) * 16; extra16 = 112; } }
    const int c = lane & 7;
#pragma unroll
    for (int j = 0; j < 4; ++j) { const int n = (lane >> 3) + 8 * j; const LAS float* s = scr + (8 * c) * 33 + n;
        u32x4 o; o.x = cvtpk(s[0 * 33], s[1 * 33]); o.y = cvtpk(s[2 * 33], s[3 * 33]); o.z = cvtpk(s[4 * 33], s[5 * 33]); o.w = cvtpk(s[6 * 33], s[7 * 33]);
        *(u32x4*)(dst + (size_t)(drow + n + (n >= 16 ? extra16 : 0)) * ldk + k0 + 8 * c) = o; }
    asm volatile("s_waitcnt lgkmcnt(0)" ::: "memory");
}

__device__ __forceinline__ void ssm_precompute(const Args& a, LAS unsigned char* lds, int job2, int tid_in) {
    const int tid = opq_v(tid_in), half = job2 >> 7, job = job2 & 127, i = job >> 6, g = job & 63, ig = i * 64 + g;
    LAS float* apr = (LAS float*)lds;
    LAS float* api = apr + 17 * 64;
    LAS float* bbr = api + 17 * 64;
    LAS float* bbi = bbr + 1024;
    LAS float* ccr = bbi + 1024;
    LAS float* cci = ccr + 1024;
    LAS float* kern = cci + 1024;
    const float* lam_re = a.in[I_LRE] + (size_t)ig * 64; const float* lam_im = a.in[I_LIM] + (size_t)ig * 64;
    const double step = exp((double)a.in[I_LSTEP][ig]);
    __syncthreads();
    for (int idx = tid; idx < 17 * 64; idx += 512) { const int d = idx >> 6, n = idx & 63;
        const double lr = (double)lam_re[n], li = (double)lam_im[n];
        const double mag = exp(lr * step * d); float sn, cs; sincos_rev(li * step * d * 0.15915494309189535, sn, cs);
        apr[idx] = (float)(mag * cs); api[idx] = (float)(mag * sn); }
    for (int idx = tid; idx < 1024; idx += 512) { ccr[idx] = a.in[I_CRE][(size_t)ig * 1024 + idx]; cci[idx] = a.in[I_CIM][(size_t)ig * 1024 + idx]; }
    __syncthreads();
    for (int idx = tid; idx < 1024; idx += 512) { const int n = idx >> 4;
        const float lr = lam_re[n], li = lam_im[n], are = apr[64 + n], aim = api[64 + n], den = lr * lr + li * li;
        const float fre = ((are - 1.0f) * lr + aim * li) / den, fim = (aim * lr - (are - 1.0f) * li) / den;
        const float br = a.in[I_BRE][(size_t)ig * 1024 + idx], bi = a.in[I_BIM][(size_t)ig * 1024 + idx];
        bbr[idx] = fre * br - fim * bi; bbi[idx] = fre * bi + fim * br; }
    __syncthreads();
    if (half == 0) {
    { const int k = (tid >> 4) & 15, kp = tid & 15, dh = tid >> 8; float s8[8];
#pragma unroll
      for (int it = 0; it < 8; ++it) s8[it] = 0.f;
      for (int n = 0; n < 64; ++n) { const float br = bbr[n * 16 + kp], bi = bbi[n * 16 + kp], cr = ccr[k * 64 + n], ci = cci[k * 64 + n];
          const float ur = cr * br - ci * bi, ui = cr * bi + ci * br;
#pragma unroll
          for (int it = 0; it < 8; ++it) { const int d = 2 * it + dh; s8[it] += apr[d * 64 + n] * ur - api[d * 64 + n] * ui; } }
#pragma unroll
      for (int it = 0; it < 8; ++it) kern[(2 * it + dh) * 256 + (tid & 255)] = s8[it]; }
    __syncthreads();
    bf16_t* bty = (bf16_t*)(a.ws + WS_BTY) + (size_t)ig * 256 * 384;
    for (int idx = tid; idx < 256 * 384; idx += 512) { const int row = idx / 384, col = idx % 384, t = row >> 4, k = row & 15; float v;
        if (col < 256) { const int j = col >> 4, kp = col & 15; v = (j <= t) ? kern[(t - j) * 256 + k * 16 + kp] : 0.f; }
        else if (col < 320) { const int n = col - 256; v = ccr[k * 64 + n] * apr[(t + 1) * 64 + n] - cci[k * 64 + n] * api[(t + 1) * 64 + n]; }
        else { const int n = col - 320; v = -(ccr[k * 64 + n] * api[(t + 1) * 64 + n] + cci[k * 64 + n] * apr[(t + 1) * 64 + n]); }
        bty[idx] = (bf16_t)(cvtpk(v, 0.f) & 0xffffu); }
    } else {
    bf16_t* btp = (bf16_t*)(a.ws + WS_BTP) + (size_t)ig * 256 * 256;
    for (int idx = tid; idx < 256 * 256; idx += 512) { const int row = idx >> 8, col = idx & 255, j = col >> 4, kp = col & 15; float v = 0.f;
        if (row < 128) { const int n = row & 63; const float pr = apr[(15 - j) * 64 + n], pi = api[(15 - j) * 64 + n], br = bbr[n * 16 + kp], bi = bbi[n * 16 + kp];
            v = (row < 64) ? (pr * br - pi * bi) : (pr * bi + pi * br); }
        btp[idx] = (bf16_t)(cvtpk(v, 0.f) & 0xffffu); }
    float* ac = (float*)(a.ws + WS_AC) + (size_t)ig * 128;
    if (tid < 64) { ac[tid] = apr[16 * 64 + tid]; ac[64 + tid] = api[16 * 64 + tid]; }
    }
    __syncthreads();
}

__device__ __forceinline__ void phase_setup(const Args& a, LAS unsigned char* lds, int tid_in) {
    const int tid = opq_v(tid_in), lane = tid & 63, wave = tid >> 6, G = opq_s(gridDim.x), bx = opq_s(blockIdx.x);
    for (int job = bx; job < 256; job += G) ssm_precompute(a, lds, job, tid_in);
    __syncthreads();
    LAS float* scr = (LAS float*)(lds + wave * 8448);
    const int gw = bx * 8 + wave, NGW = G * 8;
    unsigned char* ws = a.ws;
    constexpr int I_GU = 16 * 176, I_DN = 44 * 32, I_IN = 16 * 32, I_GL = 16 * 64, I_QA = 16 * 12, I_KVA = 16 * 9, I_QB = 6 * 48, I_KVB = 4 * 64, I_O = 16 * 32;
    constexpr int NITEMS = 4 * I_GU + 4 * I_DN + 2 * I_IN + 2 * I_GL + 2 * I_QA + I_KVA + 2 * I_QB + I_KVB + 2 * I_O;
    for (int it = gw; it < NITEMS; it += NGW) {
        int r = it;
        if (r < 4 * I_GU) { const int l = r / I_GU; tr_item(a.in[I_WGU] + (size_t)l * DM * 2 * FF, DM, 2 * FF, a.in[I_FFNN] + l * DM, (bf16_t*)(ws + WS_WGU) + (size_t)l * 2 * FF * DM, DM, 1, FF, 0, scr, r % I_GU, lane); continue; } r -= 4 * I_GU;
        if (r < 4 * I_DN) { const int l = r / I_DN; tr_item(a.in[I_WDN] + (size_t)l * FF * DM, FF, DM, nullptr, (bf16_t*)(ws + WS_WDN) + (size_t)l * DM * FF, FF, 0, 1, 0, scr, r % I_DN, lane); continue; } r -= 4 * I_DN;
        if (r < 2 * I_IN) { const int l = r / I_IN; tr_item(a.in[I_SWIN] + (size_t)l * DM * DM, DM, DM, a.in[I_MIXN] + l * DM, (bf16_t*)(ws + WS_WIN) + (size_t)l * DM * DM, DM, 0, 1, 0, scr, r % I_IN, lane); continue; } r -= 2 * I_IN;
        if (r < 2 * I_GL) { const int l = r / I_GL; tr_item(a.in[I_SGLU] + (size_t)l * DM * 2 * DM, DM, 2 * DM, nullptr, (bf16_t*)(ws + WS_WGLU) + (size_t)l * 2 * DM * DM, DM, 1, DM, 0, scr, r % I_GL, lane); continue; } r -= 2 * I_GL;
        if (r < I_QA) { tr_item(a.in[I_WQA], DM, 384, a.in[I_MIXN] + 2 * DM, (bf16_t*)(ws + WS_WQKVA), DM, 0, 1, 0, scr, r, lane); continue; } r -= I_QA;
        if (r < I_QA) { tr_item(a.in[I_WQA] + (size_t)DM * 384, DM, 384, a.in[I_MIXN] + 3 * DM, (bf16_t*)(ws + WS_WQA3), DM, 0, 1, 0, scr, r, lane); continue; } r -= I_QA;
        if (r < I_KVA) { tr_item(a.in[I_WKVA], DM, 288, a.in[I_KVINN], (bf16_t*)(ws + WS_WQKVA), DM, 0, 1, 384, scr, r, lane); continue; } r -= I_KVA;
        if (r < 2 * I_QB) { const int l = r / I_QB; tr_item(a.in[I_WQB] + (size_t)l * 384 * 1536, 384, 1536, a.in[I_QAN] + l * 384, (bf16_t*)(ws + WS_WQB) + (size_t)l * 1536 * 384, 384, 3, 1, 0, scr, r % I_QB, lane); continue; } r -= 2 * I_QB;
        if (r < I_KVB) { tr_item(a.in[I_WKVB], 256, 2048, a.in[I_KVAN], (bf16_t*)(ws + WS_WKVB), 256, 2, 1, 0, scr, r, lane); continue; } r -= I_KVB;
        { const int l = r / I_O; tr_item(a.in[I_WO] + (size_t)l * DM * DM, DM, DM, nullptr, (bf16_t*)(ws + WS_WO) + (size_t)l * DM * DM, DM, 0, 1, 0, scr, r % I_O, lane); }
    }
    { const int gt = bx * 512 + tid, NT_ = G * 512;
      u32x4* p0 = (u32x4*)((bf16_t*)(ws + WS_WQKVA) + (size_t)672 * DM); for (int i = gt; i < 96 * DM / 8; i += NT_) p0[i] = (u32x4){0u, 0u, 0u, 0u};
      u32x4* p1 = (u32x4*)((bf16_t*)(ws + WS_WQA3) + (size_t)384 * DM); for (int i = gt; i < 128 * DM / 8; i += NT_) p1[i] = (u32x4){0u, 0u, 0u, 0u};
      float* rc = (float*)(ws + WS_ROPE); float* rsn = rc + (size_t)T * 16; const int* pos = (const int*)a.in[I_POS];
      for (int i = gt; i < T * 16; i += NT_) { const int tok = i >> 4, f = i & 15; double inv = 1.0; for (int q = 0; q < f; ++q) inv *= 0.5623413251903491;
          float sn, cs; sincos_rev((double)pos[tok] * inv * 0.15915494309189535, sn, cs); rc[i] = cs; rsn[i] = sn; } }
    { const float* x = a.in[I_X]; bf16_t* xb = (bf16_t*)(ws + WS_XB); float* slots = (float*)(ws + WS_SLOT);
      for (int row0 = gw; row0 < T; row0 += 4 * NGW) { f32x4 v[4][4];
#pragma unroll
          for (int q = 0; q < 4; ++q) { const f32x4* xr = (const f32x4*)(x + (size_t)(row0 + q * NGW) * DM) + lane;
#pragma unroll
              for (int j = 0; j < 4; ++j) v[q][j] = xr[64 * j]; }
#pragma unroll
          for (int q = 0; q < 4; ++q) { const int row = row0 + q * NGW; float s = 0.f;
#pragma unroll
              for (int j = 0; j < 4; ++j) { const f32x4 t = v[q][j]; s += (t[0] * t[0] + t[1] * t[1]) + (t[2] * t[2] + t[3] * t[3]);
                  u32x2 w; w.x = cvtpk(t[0], t[1]); w.y = cvtpk(t[2], t[3]); *((u32x2*)(xb + (size_t)row * DM) + lane + 64 * j) = w; }
              s += __shfl_xor(s, 1); if ((lane & 1) == 0) slots[(size_t)row * 32 + (lane >> 1)] = s; } } }
}

__device__ __forceinline__ void phase_scan(const Args& a, int layer, int tid_in) {
    const int bx_ = opq_s(blockIdx.x), gx = bx_ & 7;
    const float* W = (const float*)(a.ws + loff_(gx, L_WST)); bf16_t* Ag = (bf16_t*)(a.ws + loff_(gx, L_AG)); const float* ac = (const float*)(a.ws + WS_AC) + (size_t)layer * 64 * 128;
    for (int gt = (bx_ >> 3) * 512 + opq_v(tid_in); gt < 4 * 64 * 64; gt += 32 * 512) {
        const int n = gt & 63, g = (gt >> 6) & 63, b = gt >> 12;
        const float ar = ac[g * 128 + n], ai = ac[g * 128 + 64 + n]; float sr = 0.f, si = 0.f;
        const size_t row0 = (size_t)g * 512 + (size_t)b * 128;
        const float* w = W + row0 * 128 + n; bf16_t* o = Ag + row0 * 384 + 256 + n;
#pragma unroll 8
        for (int m = 0; m < 128; ++m) { const float wr_ = w[(size_t)m * 128], wi_ = w[(size_t)m * 128 + 64];
            o[(size_t)m * 384] = (bf16_t)(cvtpk(sr, 0.f) & 0xffffu); o[(size_t)m * 384 + 64] = (bf16_t)(cvtpk(si, 0.f) & 0xffffu);
            const float nr = ar * sr - ai * si + wr_, ni = ar * si + ai * sr + wi_; sr = nr; si = ni; }
    }
}

__device__ __forceinline__ void phase_krope(const Args& a, int tid_in) {
    unsigned char* ws = a.ws;
    const int bx_ = opq_s(blockIdx.x), gx = bx_ & 7;
    const bf16_t* qkva = (const bf16_t*)(ws + voff(gx, L_QKVA, 1536)); const float* slots2 = (const float*)(ws + WS_SLOT2);
    bf16_t* KR = (bf16_t*)(ws + voff(gx, L_KR, 64)); const float* rc = (const float*)(ws + WS_ROPE); const float* rsn = rc + (size_t)T * 16;
    const float* gkr = a.in[I_KROPEN];
    for (int gt = (bx_ >> 3) * 512 + opq_v(tid_in); gt < (int)GTOK * 4; gt += 32 * 512) { const int tok = gx * (int)GTOK + (gt >> 2), qd = gt & 3;
        const u32x2 w1 = *(const u32x2*)(qkva + (size_t)tok * 768 + 640 + 4 * qd), w2 = *(const u32x2*)(qkva + (size_t)tok * 768 + 656 + 4 * qd);
        const float r = rsqrtf(slots2[(size_t)tok * 32 + 20] * (1.0f / 32) + EPS);
        const float x1[4] = {bflo(w1.x), bfhi(w1.x), bflo(w1.y), bfhi(w1.y)}, x2[4] = {bflo(w2.x), bfhi(w2.x), bflo(w2.y), bfhi(w2.y)}; float o1[4], o2[4];
#pragma unroll
        for (int e = 0; e < 4; ++e) { const int i = 4 * qd + e; const float a1 = x1[e] * r * gkr[i], a2 = x2[e] * r * gkr[16 + i], c = rc[(size_t)tok * 16 + i], s = rsn[(size_t)tok * 16 + i];
            o1[e] = a1 * c - a2 * s; o2[e] = a1 * s + a2 * c; }
        u32x2 p1, p2; p1.x = cvtpk(o1[0], o1[1]); p1.y = cvtpk(o1[2], o1[3]); p2.x = cvtpk(o2[0], o2[1]); p2.y = cvtpk(o2[2], o2[3]);
        *(u32x2*)(KR + (size_t)tok * 32 + 4 * qd) = p1; *(u32x2*)(KR + (size_t)tok * 32 + 16 + 4 * qd) = p2; }
}

__device__ __forceinline__ int crow(int r, int hi) { return (r & 3) + 8 * (r >> 2) + 4 * hi; }
constexpr int AT_KROW = 208, AT_KBUF = 64 * AT_KROW, AT_VROW = 136, AT_VBUF = 64 * AT_VROW, AT_VOFF = 2 * AT_KBUF;
template <bool FIXED>
__device__ __forceinline__ void attn_unit(LAS unsigned char* lds, const bf16_t* Q, const bf16_t* Kf, const bf16_t* KR, const bf16_t* Vt, bf16_t* O, int b, int h, int qb, int tid_in, float negB) {
    const int tid = opq_v(tid_in), lane = tid & 63, r32 = lane & 31, hi = lane >> 5; const int wid = __builtin_amdgcn_readfirstlane(tid >> 6);
    const int q0 = qb * 256; const size_t rowbase = (size_t)b * SEQ;
    const int qabs = q0 + wid * 32 + r32;
    bf16x8 qf[6];
    { const bf16_t* qp = Q + (rowbase + qabs) * 1536 + h * 96 + hi * 8;
#pragma unroll
      for (int s = 0; s < 6; ++s) qf[s] = *(const bf16x8*)(qp + 16 * s); }
    const int NT_ = (q0 + 256) / 64;
    const int kr0 = tid / 12, kp0 = tid % 12, kr1 = (512 + tid) / 12, kp1 = (512 + tid) % 12; const bool k2 = tid < 256;
    const bf16_t* kg0 = (kp0 < 8) ? Kf + (rowbase + kr0) * 1024 + h * 64 + kp0 * 8 : KR + (rowbase + kr0) * 32 + (kp0 - 8) * 8;
    const bf16_t* kg1 = (kp1 < 8) ? Kf + (rowbase + kr1) * 1024 + h * 64 + kp1 * 8 : KR + (rowbase + kr1) * 32 + (kp1 - 8) * 8;
    const size_t ks0 = (kp0 < 8) ? (size_t)64 * 1024 : (size_t)64 * 32, ks1 = (kp1 < 8) ? (size_t)64 * 1024 : (size_t)64 * 32;
    const int kl0 = kr0 * AT_KROW + kp0 * 16, kl1 = kr1 * AT_KROW + kp1 * 16;
    const int vd = tid >> 3, vp = tid & 7;
    const bf16_t* vg = Vt + ((size_t)(b * NH + h) * 64 + vd) * SEQ + vp * 8;
    const int vl = AT_VOFF + vd * AT_VROW + vp * 16;
    u32x4 kreg0, kreg1 = (u32x4){0u, 0u, 0u, 0u}, vreg;
    kreg0 = *(const u32x4*)kg0; if (k2) kreg1 = *(const u32x4*)kg1; vreg = *(const u32x4*)vg;
    *(LAS u32x4*)(lds + kl0) = kreg0; if (k2) *(LAS u32x4*)(lds + kl1) = kreg1;
    *(LAS u32x2*)(lds + vl) = (u32x2){vreg.x, vreg.y}; *(LAS u32x2*)(lds + vl + 8) = (u32x2){vreg.z, vreg.w};
    __syncthreads();
    float m_run = -1e30f, l_run = 0.f; f32x16 o0, o1, cinit;
#pragma unroll
    for (int r = 0; r < 16; ++r) { o0[r] = 0.f; o1[r] = 0.f; cinit[r] = FIXED ? negB : 0.f; }
    for (int t = 0; t < NT_; ++t) {
        const bool pre = (t + 1 < NT_);
        if (pre) { kreg0 = *(const u32x4*)(kg0 + (size_t)(t + 1) * ks0); if (k2) kreg1 = *(const u32x4*)(kg1 + (size_t)(t + 1) * ks1); vreg = *(const u32x4*)(vg + (t + 1) * 64); }
        const int kv0 = t * 64;
        if (kv0 <= q0 + wid * 32 + 31) {
            const LAS unsigned char* kb = lds + (t & 1) * AT_KBUF + r32 * AT_KROW + hi * 16;
            const LAS unsigned char* vb = lds + AT_VOFF + (t & 1) * AT_VBUF + r32 * AT_VROW + hi * 8;
            f32x16 s0, s1;
            { bf16x8 kf[12];
#pragma unroll
              for (int s = 0; s < 6; ++s) { kf[2 * s] = *(const LAS bf16x8*)(kb + s * 32); kf[2 * s + 1] = *(const LAS bf16x8*)(kb + 32 * AT_KROW + s * 32); }
              asm volatile("s_waitcnt lgkmcnt(0)" ::: "memory"); __builtin_amdgcn_sched_barrier(0);
#pragma unroll
              for (int s = 0; s < 6; ++s) { s0 = __builtin_amdgcn_mfma_f32_32x32x16_bf16(kf[2 * s], qf[s], s == 0 ? cinit : s0, 0, 0, 0); s1 = __builtin_amdgcn_mfma_f32_32x32x16_bf16(kf[2 * s + 1], qf[s], s == 0 ? cinit : s1, 0, 0, 0); } }
            __builtin_amdgcn_sched_barrier(0);
            u32x2 vf[16];
#pragma unroll
            for (int s = 0; s < 4; ++s) { vf[4 * s] = *(const LAS u32x2*)(vb + s * 32); vf[4 * s + 1] = *(const LAS u32x2*)(vb + s * 32 + 16);
                vf[4 * s + 2] = *(const LAS u32x2*)(vb + 32 * AT_VROW + s * 32); vf[4 * s + 3] = *(const LAS u32x2*)(vb + 32 * AT_VROW + s * 32 + 16); }
            if (kv0 + 63 > q0 + wid * 32) {
#pragma unroll
                for (int r = 0; r < 16; ++r) { const int kv = kv0 + crow(r, hi); if (kv > qabs) s0[r] = -1e30f; if (kv + 32 > qabs) s1[r] = -1e30f; }
            }
            if (FIXED) {
                float ps = 0.f;
#pragma unroll
                for (int r = 0; r < 16; ++r) { s0[r] = __builtin_amdgcn_exp2f(s0[r]); s1[r] = __builtin_amdgcn_exp2f(s1[r]); ps += s0[r] + s1[r]; }
                l_run += ps;
            } else {
                float mx = fmaxf(s0[0], s1[0]);
#pragma unroll
                for (int r = 1; r < 16; ++r) mx = fmaxf(mx, fmaxf(s0[r], s1[r]));
                mx = fmaxf(mx, __shfl_xor(mx, 32));
                const float m_new = fmaxf(m_run, mx), alpha = __builtin_amdgcn_exp2f(m_run - m_new); m_run = m_new;
                float ps = 0.f;
#pragma unroll
                for (int r = 0; r < 16; ++r) { s0[r] = __builtin_amdgcn_exp2f(s0[r] - m_new); s1[r] = __builtin_amdgcn_exp2f(s1[r] - m_new); ps += s0[r] + s1[r]; }
                l_run = l_run * alpha + ps;
#pragma unroll
                for (int r = 0; r < 16; ++r) { o0[r] *= alpha; o1[r] *= alpha; }
            }
            bf16x8 pk[4];
#pragma unroll
            for (int s = 0; s < 4; ++s) { u32x4 w;
#pragma unroll
                for (int e = 0; e < 4; ++e) { const int r = 8 * (s & 1) + 2 * e; w[e] = (s < 2) ? cvtpk(s0[r], s0[r + 1]) : cvtpk(s1[r], s1[r + 1]); }
                pk[s] = __builtin_bit_cast(bf16x8, w); }
            asm volatile("s_waitcnt lgkmcnt(0)" ::: "memory"); __builtin_amdgcn_sched_barrier(0);
#pragma unroll
            for (int s = 0; s < 4; ++s) {
                { const u32x4 w = (u32x4){vf[4 * s].x, vf[4 * s].y, vf[4 * s + 1].x, vf[4 * s + 1].y}; o0 = __builtin_amdgcn_mfma_f32_32x32x16_bf16(__builtin_bit_cast(bf16x8, w), pk[s], o0, 0, 0, 0); }
                { const u32x4 w = (u32x4){vf[4 * s + 2].x, vf[4 * s + 2].y, vf[4 * s + 3].x, vf[4 * s + 3].y}; o1 = __builtin_amdgcn_mfma_f32_32x32x16_bf16(__builtin_bit_cast(bf16x8, w), pk[s], o1, 0, 0, 0); }
            }
        }
        if (pre) { const int bo = ((t + 1) & 1); *(LAS u32x4*)(lds + bo * AT_KBUF + kl0) = kreg0; if (k2) *(LAS u32x4*)(lds + bo * AT_KBUF + kl1) = kreg1;
            *(LAS u32x2*)(lds + bo * AT_VBUF + vl) = (u32x2){vreg.x, vreg.y}; *(LAS u32x2*)(lds + bo * AT_VBUF + vl + 8) = (u32x2){vreg.z, vreg.w}; }
        __syncthreads();
    }
    const float lt = l_run + __shfl_xor(l_run, 32), inv = 1.0f / lt;
    bf16_t* op = O + (rowbase + qabs) * DM + h * 64 + 4 * hi;
#pragma unroll
    for (int g = 0; g < 4; ++g) { u32x2 w; w.x = cvtpk(o0[4 * g] * inv, o0[4 * g + 1] * inv); w.y = cvtpk(o0[4 * g + 2] * inv, o0[4 * g + 3] * inv); *(u32x2*)(op + 8 * g) = w;
        u32x2 w2; w2.x = cvtpk(o1[4 * g] * inv, o1[4 * g + 1] * inv); w2.y = cvtpk(o1[4 * g + 2] * inv, o1[4 * g + 3] * inv); *(u32x2*)(op + 32 + 8 * g) = w2; }
}
__device__ __forceinline__ float wave_max(float v) {
#pragma unroll
    for (int o = 1; o < 64; o <<= 1) v = fmaxf(v, __shfl_xor(v, o));
    return v;
}
__device__ __forceinline__ void phase_attn(const Args& a, LAS unsigned char* lds, int tid_in, int j) {
    const int gx_ = opq_s(blockIdx.x) & 7;
    const bf16_t* Q = (const bf16_t*)(a.ws + voff(gx_, L_QRAW, 3072)); const bf16_t* Kf = (const bf16_t*)(a.ws + voff(gx_, L_KF, 2048)); const bf16_t* KR = (const bf16_t*)(a.ws + voff(gx_, L_KR, 64)); const bf16_t* Vt = (const bf16_t*)(a.ws + voff(gx_, L_VT, 2048)); bf16_t* O = (bf16_t*)(a.ws + voff(gx_, L_O, 2048));
    float B;
    { const int lane = opq_v(tid_in) & 63;
      const float gqn = wave_max(fabsf(a.in[I_QNOPEN][j * 64 + lane])), gkn = wave_max(fabsf(a.in[I_KNOPEN][lane]));
      const float gqr = wave_max(fabsf(a.in[I_QROPEN][j * 32 + (lane & 31)])), gkr = wave_max(fabsf(a.in[I_KROPEN][lane & 31]));
      B = sqrtf(64.f * gqn * gqn + 32.f * gqr * gqr) * sqrtf(64.f * gkn * gkn + 32.f * gkr * gkr) * QSCALE * 1.02f; }
    const bool fixed = (B <= 40.0f);
    const int bx = opq_s(blockIdx.x); const int vcu = (bx & 7) * 32 + (bx >> 3);
    for (int p = vcu * 8; p < vcu * 8 + 8; ++p) {
        const int bh = p >> 2, s = p & 3;
        if (fixed) { attn_unit<true>(lds, Q, Kf, KR, Vt, O, bh / NH, bh % NH, 7 - s, tid_in, -B); attn_unit<true>(lds, Q, Kf, KR, Vt, O, bh / NH, bh % NH, s, tid_in, -B); }
        else { attn_unit<false>(lds, Q, Kf, KR, Vt, O, bh / NH, bh % NH, 7 - s, tid_in, 0.f); attn_unit<false>(lds, Q, Kf, KR, Vt, O, bh / NH, bh % NH, s, tid_in, 0.f); }
    }
}

#define XB_TMO      128
#define XB_XCNT(j)  (256  + 64 * (j))
#define XB_XSUB(j)  (1280 + 64 * (j))
#define XB_XGEN(j)  (2304 + 64 * (j))
#define XB_TOP      3328
#define XB_TOPGEN   3392
#define XCD_BAR_WORDS 3456
#define XB_SPIN_CAP (1u << 18)

__device__ __forceinline__ unsigned xb_ld(unsigned* p)              { return __hip_atomic_load(p, __ATOMIC_RELAXED, __HIP_MEMORY_SCOPE_AGENT); }
__device__ __forceinline__ unsigned xb_add(unsigned* p, unsigned v) { return __hip_atomic_fetch_add(p, v, __ATOMIC_RELAXED, __HIP_MEMORY_SCOPE_AGENT); }
__device__ __forceinline__ unsigned xb_xcc_id() { return (unsigned)__builtin_amdgcn_s_getreg((3 << 11) | 20) & 0xFu; }
#define XB_SPIN(cond, bar) do { unsigned _sp = 0; while (cond) { __builtin_amdgcn_s_sleep(1); \
    if ((++_sp & 255u) == 0u) { if (xb_ld(&(bar)[XB_TMO])) break; if (_sp > XB_SPIN_CAP) { atomicAdd(&(bar)[XB_TMO], 1u); break; } } } } while (0)

#ifndef GB_SKIP_WB
#define GB_SKIP_WB 1
#endif
struct XcdBarrier {
    unsigned* bar; unsigned x; unsigned gsz;
    volatile LAS unsigned* st;
};

__device__ __forceinline__ XcdBarrier xcd_barrier_post(unsigned* bar, volatile LAS unsigned* st) {
    XcdBarrier b; b.bar = bar; b.x = xb_xcc_id(); b.st = st;
    if (threadIdx.x == 0) (void)xb_add(&bar[XB_XCNT(b.x)], 1u);
    return b;
}
__device__ __forceinline__ void xcd_barrier_complete(unsigned* bar, unsigned x, unsigned& nloc, unsigned& nx, unsigned G) {
    unsigned sum, cnt, mine, sp = 0u;
    for (;;) {
        sum = 0u; cnt = 0u; mine = 0u;
#pragma unroll
        for (unsigned j = 0; j < 16; ++j) { const unsigned c = xb_ld(&bar[XB_XCNT(j)]); sum += c; cnt += (c > 0u) ? 1u : 0u; mine = (j == x) ? c : mine; }
        if (sum == G) break;
        __builtin_amdgcn_s_sleep(1);
        if ((++sp & 255u) == 0u) { if (xb_ld(&bar[XB_TMO])) break; if (sp > XB_SPIN_CAP) { atomicAdd(&bar[XB_TMO], 1u); break; } }
    }
    nloc = mine > 0u ? mine : 1u; nx = cnt > 0u ? cnt : 1u;
}

__device__ __forceinline__ void xcd_barrier(const XcdBarrier& b, int tid_in) {
    asm volatile("s_waitcnt vmcnt(0)" ::: "memory");
    __syncthreads();
    if (tid_in == 0) {
        unsigned* bar = b.bar; asm volatile("" : "+s"(bar));
        __builtin_amdgcn_s_waitcnt(0);
        unsigned nloc = b.st[0], nx = b.st[1];
        if (nloc == 0u) { xcd_barrier_complete(bar, b.x, nloc, nx, b.gsz); b.st[0] = nloc; b.st[1] = nx; }
        const unsigned old = xb_add(&bar[XB_XSUB(b.x)], 1u);
        const unsigned gen = old / nloc;
        if (old + 1u == (gen + 1u) * nloc) {
            if (GB_SKIP_WB == 0 || nx > 1u) {
            __builtin_amdgcn_fence(__ATOMIC_RELEASE, "agent");
            asm volatile("s_waitcnt vmcnt(0)" ::: "memory"); }
            const unsigned og = xb_add(&bar[XB_TOP], 1u);
            const unsigned tg = og / nx;
            if (og + 1u == (tg + 1u) * nx) xb_add(&bar[XB_TOPGEN], 1u);
            else XB_SPIN(xb_ld(&bar[XB_TOPGEN]) == tg, bar);
            __builtin_amdgcn_fence(__ATOMIC_ACQUIRE, "agent");
            xb_add(&bar[XB_XGEN(b.x)], 1u);
            asm volatile("s_waitcnt vmcnt(0)" ::: "memory");
        } else {
            XB_SPIN(xb_ld(&bar[XB_XGEN(b.x)]) == gen, bar);
            __builtin_amdgcn_fence(__ATOMIC_ACQUIRE, "agent");
            asm volatile("s_waitcnt vmcnt(0)" ::: "memory");
        }
    }
    __syncthreads();
}

#ifndef PHMASK
#define PHMASK 0xFFFFFFFFu
#endif
#define EN(k) (((PHMASK) >> (k)) & 1u)
#ifndef REPMASK
#define REPMASK 0u
#endif
#define REP(k) (((REPMASK) >> (k)) & 1u)
constexpr int LDS_BYTES = 131072 + 256;
#if defined(__HIP_DEVICE_COMPILE__)
typedef const __attribute__((address_space(4))) Args* kargs_t;
#else
typedef const Args* kargs_t;
#endif
__device__ __forceinline__ kargs_t args_ptr() {
    unsigned long long v = (unsigned long long)__builtin_amdgcn_kernarg_segment_ptr(); asm volatile("" : "+s"(v)); return (kargs_t)v;
}
__global__ void __launch_bounds__(512, 2) yoco_fwd(Args a0) {
    extern __shared__ __attribute__((aligned(16))) unsigned char lds_raw[];
    LAS unsigned char* lds = (LAS unsigned char*)lds_raw;
    cg::grid_group grid = cg::this_grid();
    const int G = gridDim.x, bx = blockIdx.x;
    const int s_wid = __builtin_amdgcn_readfirstlane((int)threadIdx.x >> 6);
#define TIDV ((s_wid << 6) | lane_id_opq())
    if (threadIdx.x < 64) ((LAS unsigned*)(lds + 131072))[threadIdx.x] = 0u;
    __syncthreads();
    XcdBarrier xbar = xcd_barrier_post((unsigned*)(a0.ws + WS_BAR + (size_t)(bx & 7) * WS_BAR_GRP), (volatile LAS unsigned*)(lds + 131072)); xbar.gsz = 32u;
#define GRID_SYNC() xcd_barrier(xbar, TIDV)
#define PHASE_BEGIN(k) { for (int rep_ = 0; rep_ <= (int)REP(k); ++rep_) { if (rep_) GRID_SYNC(); const Args a = *args_ptr(); unsigned char* ws = a.ws; const int gx = opq_s(bx) & 7; (void)gx; bf16_t* xb = (bf16_t*)(ws + WS_XB); float* slots = (float*)(ws + WS_SLOT); float* slots2 = (float*)(ws + WS_SLOT2); (void)xb; (void)slots; (void)slots2;
#define PHASE_END   } GRID_SYNC(); }
#define PHASE_END_LAST(cond) } if (cond) GRID_SYNC(); }
    using namespace pg8;
#ifdef EXTRA_SYNCS
    for (int i_ = 0; i_ < EXTRA_SYNCS; ++i_) GRID_SYNC();
#endif
    PHASE_BEGIN(0) phase_setup(a, lds, TIDV); } grid.sync(); }
#pragma unroll 1
    for (int layer = 0; layer < 4; ++layer) {
        if (layer < 2) {
            PHASE_BEGIN(1) { Gemm g{xb, (const bf16_t*)(ws + WS_WIN) + (size_t)layer * DM * DM, DM, DM, DM, 0, 0}; Sched S; S.init(T, DM, 1, opq_s(G), opq_s(bx));
                EpiScaleBf16<1, false> E{(bf16_t*)(ws + voff(gx, L_AG, 48)), 0, RowScale{slots, 0, 8, 1.0f / DM}, nullptr}; gemm_phase<EpiScaleBf16<1, false>, true>(lds, g, S, E, TIDV); } PHASE_END
            PHASE_BEGIN(2) { Gemm g{(const bf16_t*)(ws + loff_(gx, L_AG)), (const bf16_t*)(ws + WS_BTP) + (size_t)layer * 64 * 256 * 256, 256, 384, 256, 512L * 384, 256L * 256}; Sched S; S.init_local(1, opq_s(bx));
                EpiSsmP E{(float*)(ws + loff_(gx, L_WST))}; gemm_phase<EpiSsmP, true>(lds, g, S, E, TIDV); } PHASE_END
            PHASE_BEGIN(3) phase_scan(a, layer, TIDV); PHASE_END
            PHASE_BEGIN(4) { Gemm g{(const bf16_t*)(ws + loff_(gx, L_AG)), (const bf16_t*)(ws + WS_BTY) + (size_t)layer * 64 * 256 * 384, 384, 384, 384, 512L * 384, 256L * 384}; Sched S; S.init_local(1, opq_s(bx));
                EpiSsmY E{(const bf16_t*)(ws + loff_(gx, L_AG)), a.in[I_SD] + layer * DM, (bf16_t*)(ws + loff_(gx, L_Z))}; gemm_phase<EpiSsmY, true>(lds, g, S, E, TIDV); } PHASE_END
            PHASE_BEGIN(5) { Gemm g{(const bf16_t*)(ws + voff(gx, L_Z, 2048)), (const bf16_t*)(ws + WS_WGLU) + (size_t)layer * 2 * DM * DM, DM, DM, DM, 0, 0}; Sched S; S.init(T, 2 * DM, 1, opq_s(G), opq_s(bx));
                EpiRes<true> E{a.out, xb, slots, false}; gemm_phase<EpiRes<true>, true>(lds, g, S, E, TIDV); } PHASE_END
        } else {
            const int j = layer - 2;
            if (j == 0) {
                PHASE_BEGIN(6) { Gemm g{xb, (const bf16_t*)(ws + WS_WQKVA), DM, DM, DM, 0, 0}; Sched S; S.init(T, 768, 1, opq_s(G), opq_s(bx));
                    EpiScaleBf16<0, true> E{(bf16_t*)(ws + voff(gx, L_QKVA, 1536)), 768, RowScale{slots, 0, 8, 1.0f / DM}, slots2}; gemm_phase<EpiScaleBf16<0, true>, true>(lds, g, S, E, TIDV); } PHASE_END
                PHASE_BEGIN(7) { phase_krope(a, TIDV);
                    { Gemm g{(const bf16_t*)(ws + voff(gx, L_QKVA, 1536)) + 384, (const bf16_t*)(ws + WS_WKVB), 256, 768, 256, 0, 0}; Sched S; S.init(T, 1024, 1, opq_s(G), opq_s(bx));
                      EpiHead E{(bf16_t*)(ws + voff(gx, L_KF, 2048)), RowScale{slots2, 12, 2, 1.0f / 256}, a.in[I_KNOPEN], nullptr, nullptr, nullptr, 1.0f, 1024, 64}; gemm_phase<EpiHead, true>(lds, g, S, E, TIDV); }
                    { Gemm g{(const bf16_t*)(ws + WS_WKVB) + (size_t)1024 * 256, (const bf16_t*)(ws + voff(gx, L_QKVA, 1536)) + 384, 256, 256, 768, 0, 0}; Sched S; S.init_local(2, opq_s(bx));
                      EpiVt E{(bf16_t*)(ws + voff(gx, L_VT, 2048)), slots2}; gemm_phase<EpiVt, true>(lds, g, S, E, TIDV); }
                    { Gemm g{(const bf16_t*)(ws + voff(gx, L_QKVA, 1536)), (const bf16_t*)(ws + WS_WQB), 384, 768, 384, 0, 0}; Sched S; S.init(T, 1536, 1, opq_s(G), opq_s(bx));
                      EpiHead E{(bf16_t*)(ws + voff(gx, L_QRAW, 3072)), RowScale{slots2, 0, 3, 1.0f / 384}, a.in[I_QNOPEN], a.in[I_QROPEN], (const float*)(ws + WS_ROPE), (const float*)(ws + WS_ROPE) + (size_t)T * 16, QSCALE, 1536, 96}; gemm_phase<EpiHead, true>(lds, g, S, E, TIDV); } } PHASE_END
            } else {
                PHASE_BEGIN(10) { Gemm g{xb, (const bf16_t*)(ws + WS_WQA3), DM, DM, DM, 0, 0}; Sched S; S.init(T, 512, 1, opq_s(G), opq_s(bx));
                    EpiScaleBf16<0, true> E{(bf16_t*)(ws + voff(gx, L_QKVA, 1024)), 512, RowScale{slots, 0, 8, 1.0f / DM}, slots2}; gemm_phase<EpiScaleBf16<0, true>, true>(lds, g, S, E, TIDV); } PHASE_END
                PHASE_BEGIN(11) { Gemm g{(const bf16_t*)(ws + voff(gx, L_QKVA, 1024)), (const bf16_t*)(ws + WS_WQB) + (size_t)1536 * 384, 384, 512, 384, 0, 0}; Sched S; S.init(T, 1536, 1, opq_s(G), opq_s(bx));
                    EpiHead E{(bf16_t*)(ws + voff(gx, L_QRAW, 3072)), RowScale{slots2, 0, 3, 1.0f / 384}, a.in[I_QNOPEN] + 64, a.in[I_QROPEN] + 32, (const float*)(ws + WS_ROPE), (const float*)(ws + WS_ROPE) + (size_t)T * 16, QSCALE, 1536, 96}; gemm_phase<EpiHead, true>(lds, g, S, E, TIDV); } PHASE_END
            }
            PHASE_BEGIN(13) phase_attn(a, lds, TIDV, j); PHASE_END
            PHASE_BEGIN(14) { Gemm g{(const bf16_t*)(ws + voff(gx, L_O, 2048)), (const bf16_t*)(ws + WS_WO) + (size_t)j * DM * DM, DM, DM, DM, 0, 0}; Sched S; S.init(T, DM, 1, opq_s(G), opq_s(bx));
                EpiRes<false> E{a.out, xb, slots, false}; gemm_phase<EpiRes<false>, true>(lds, g, S, E, TIDV); } PHASE_END
        }
        PHASE_BEGIN(15) { Gemm g{xb, (const bf16_t*)(ws + WS_WGU) + (size_t)layer * 2 * FF * DM, DM, DM, DM, 0, 0}; Sched S; S.init(T, 2 * FF, 1, opq_s(G), opq_s(bx));
            EpiSwiGLU E{(bf16_t*)(ws + voff(gx, L_FFA, 5632)), RowScale{slots, 0, 8, 1.0f / DM}}; gemm_phase<EpiSwiGLU, true>(lds, g, S, E, TIDV); } PHASE_END
        PHASE_BEGIN(16) { Gemm g{(const bf16_t*)(ws + voff(gx, L_FFA, 5632)), (const bf16_t*)(ws + WS_WDN) + (size_t)layer * DM * FF, FF, FF, FF, 0, 0}; Sched S; S.init(T, DM, 1, opq_s(G), opq_s(bx));
            EpiRes<false> E{a.out, xb, slots, layer == 3}; gemm_phase<EpiRes<false>, true>(lds, g, S, E, TIDV); } PHASE_END_LAST(layer < 3)
    }
}

extern "C" void kernel_launch(void* const* d_in, const int* in_sizes, int n_in, void* d_out, int out_size, void* d_ws, size_t ws_size, hipStream_t stream) {
    static int grid = 0;
    if (grid == 0) {
        if (n_in != N_IN || out_size != T * DM || ws_size < WS_END) { fprintf(stderr, "kernel_launch: unexpected shapes (n_in %d out %d ws %zu)\n", n_in, out_size, ws_size); grid = -1; return; }
        int dev = 0, cus = 0, per = 0;
        (void)hipGetDevice(&dev); (void)hipDeviceGetAttribute(&cus, hipDeviceAttributeMultiprocessorCount, dev);
        (void)hipFuncSetAttribute((const void*)yoco_fwd, hipFuncAttributeMaxDynamicSharedMemorySize, LDS_BYTES);
        (void)hipOccupancyMaxActiveBlocksPerMultiprocessor(&per, (const void*)yoco_fwd, 512, LDS_BYTES);
        if (per < 1) per = 1;
        grid = cus * per;
        if (grid != 256) { fprintf(stderr, "kernel_launch: this build needs a 256-workgroup grid (8 groups of 32), got %d; nothing launched\n", grid); grid = -1; return; }
        fprintf(stderr, "kernel_launch: grid %d (cus %d x %d)\n", grid, cus, per);
    }
    if (grid < 0) return;
    (void)hipMemsetAsync((unsigned char*)d_ws + WS_BAR, 0, WS_BAR_BYTES, stream);
    Args a{};
    for (int i = 0; i < N_IN; ++i) a.in[i] = (const float*)d_in[i];
    a.out = (float*)d_out; a.ws = (unsigned char*)d_ws; a.ph_lo = 0; a.ph_hi = 1000;
    void* args[] = {&a};
    hipError_t e = hipLaunchCooperativeKernel((const void*)yoco_fwd, dim3(grid), dim3(512), args, LDS_BYTES, stream);
    if (e != hipSuccess) fprintf(stderr, "kernel_launch: cooperative launch failed: %s (grid %d)\n", hipGetErrorString(e), grid);
}
```

```cpp
#include <hip/hip_runtime.h>
#include <hip/hip_cooperative_groups.h>
#include <cstdio>
#include <cstdint>
namespace cg = cooperative_groups;

#define LAS __attribute__((address_space(3)))
typedef unsigned short bf16_t;
typedef short bf16x8 __attribute__((ext_vector_type(8)));
typedef float f32x4 __attribute__((ext_vector_type(4)));
typedef float f32x16 __attribute__((ext_vector_type(16)));
typedef unsigned u32x4 __attribute__((ext_vector_type(4)));
typedef unsigned u32x2 __attribute__((ext_vector_type(2)));
typedef float f32x2_t __attribute__((ext_vector_type(2)));
typedef __bf16 bf16x2_t __attribute__((ext_vector_type(2)));

constexpr int T = 65536, DM = 1024, SEQ = 2048, NB = 32, FF = 2816, NH = 16;
constexpr float EPS = 1e-6f;
constexpr float QSCALE = 0.14724444f;

constexpr size_t MiB = 1u << 20;
constexpr size_t WS_WIN = 0, WS_WGLU = 4 * MiB, WS_WGU = 12 * MiB, WS_WDN = 56 * MiB, WS_WQKVA = 78 * MiB, WS_WQA3 = 80 * MiB,
                 WS_WQB = 81 * MiB, WS_WKVB = 84 * MiB, WS_WO = 85 * MiB, WS_BTY = 90 * MiB, WS_BTP = 114 * MiB, WS_AC = 130 * MiB,
                 WS_ROPE = 131 * MiB, WS_SLOT = 139 * MiB, WS_SLOT2 = 147 * MiB, WS_XB = 155 * MiB,
                 WS_KF = 283 * MiB, WS_VT = 475 * MiB, WS_R = 603 * MiB, WS_END = 1024 * MiB;
constexpr size_t WS_BAR = 130 * MiB + 512 * 1024, WS_BAR_GRP = 16384, WS_BAR_BYTES = 8 * WS_BAR_GRP;
constexpr size_t SLICE0 = 283 * MiB, SLICE = (741 * MiB) / 8, GTOK = 8192;
constexpr size_t L_KF = 0, L_KR = 16 * MiB, L_AG = 0, L_VT = 24 * MiB, L_WST = 24 * MiB, L_R = 40 * MiB, L_FFA = L_R, L_Z = L_R, L_QRAW = L_R, L_O = L_R + 24 * MiB + 512 * 1024, L_QKVA = L_R + 37 * MiB + 512 * 1024;
__host__ __device__ __forceinline__ size_t voff(int gx, size_t loff, size_t rowbytes) { return SLICE0 + loff + (size_t)gx * (SLICE - GTOK * rowbytes); }
__host__ __device__ __forceinline__ size_t loff_(int gx, size_t loff) { return SLICE0 + loff + (size_t)gx * SLICE; }

enum { I_X = 0, I_POS, I_MIXN, I_FFNN, I_WGU, I_WDN, I_SWIN, I_LRE, I_LIM, I_LSTEP, I_BRE, I_BIM, I_CRE, I_CIM, I_SD, I_SGLU,
       I_KVINN, I_WKVA, I_KVAN, I_WKVB, I_KNOPEN, I_KROPEN, I_WQA, I_QAN, I_WQB, I_QNOPEN, I_QROPEN, I_WO, N_IN };

__device__ __forceinline__ int opq_v(int v) { asm volatile("" : "+v"(v)); return v; }
__device__ __forceinline__ int opq_s(int v) { asm volatile("" : "+s"(v)); return v; }
__device__ __forceinline__ int lane_id_opq() { unsigned z = 0u; asm volatile("" : "+v"(z)); return (int)__builtin_amdgcn_mbcnt_hi(~0u, __builtin_amdgcn_mbcnt_lo(~0u, z)); }
__device__ __forceinline__ unsigned cvtpk(float lo, float hi) { f32x2_t v = {lo, hi}; bf16x2_t b = __builtin_convertvector(v, bf16x2_t); return __builtin_bit_cast(unsigned, b); }
__device__ __forceinline__ float bflo(unsigned w) { return __uint_as_float(w << 16); }
__device__ __forceinline__ float bfhi(unsigned w) { return __uint_as_float(w & 0xffff0000u); }
__device__ __forceinline__ float sigmoidf_(float x) { return __builtin_amdgcn_rcpf(1.0f + __builtin_amdgcn_exp2f(-1.4426950408889634f * x)); }
__device__ __forceinline__ float gelu_tanh(float x) { const float u = 1.5957691216057308f * (x + 0.044715f * x * x * x); return x * sigmoidf_(u); }

namespace pg8 {
constexpr int BM = 256, BK = 64, HALF = 128, HTB = HALF * BK * 2, STAGE_BYTES = 8 * HTB, NXCD = 8, WGM = 8;
__host__ __device__ __forceinline__ int lds_byte(int r, int c) { const int st = (r >> 4) * 2 + (c >> 5), rr = r & 15, cc = c & 31, ob = rr * 64 + cc * 2; return st * 1024 + (ob ^ (((ob >> 9) & 1) << 5)); }
__host__ __device__ __forceinline__ void stage_rc(int b, int& R, int& C) { const int st = b / 1024, sb = b % 1024, swz = sb ^ (((sb >> 9) & 1) << 5); R = (st >> 1) * 16 + swz / 64; C = (st & 1) * 32 + (swz % 64) / 2; }
__host__ __device__ __forceinline__ int perm32(int rho) { const int n = rho >> 4, i = rho & 15; return 8 * (i >> 2) + 4 * n + (i & 3); }

struct Unit { int pm, pn, pg; };
struct Gemm { const bf16_t* A; const bf16_t* Bt; int K, lda, ldb; long gsA, gsB; };

struct Sched {
    int nM, nN, nwg, nG, G, c, mode;
    __device__ void init(int M, int N, int nG_, int G_, int c_) { nM = M / BM; nN = N / BM; nwg = nM * nN; nG = nG_; G = G_; c = c_; mode = 0; }
    __device__ void init_local(int mode_, int c_) { nM = nN = nwg = nG = 1; G = 256; c = c_; mode = mode_; }
    __device__ bool next(int i, Unit& u) const {
        if (mode == 1) { if (i >= 4) return false; const int j = (c >> 3) + 32 * i; u.pg = j >> 1; u.pm = j & 1; u.pn = 0; return true; }
        if (mode == 2) { if (i >= 4) return false; const int j = (c >> 3) + 32 * i; u.pg = 0; u.pm = j & 3; u.pn = 32 * (c & 7) + (j >> 2); return true; }
        const long L = (long)i * G + c; if (L >= (long)nwg * nG) return false;
        u.pg = (int)(L / nwg); int wgid = (int)(L % nwg);
        { const int q = nwg / NXCD, r = nwg % NXCD, xcd = wgid % NXCD, off = wgid / NXCD; wgid = (xcd < r ? xcd * (q + 1) : r * (q + 1) + (xcd - r) * q) + off; }
        const int nig = WGM * nN, gid = wgid / nig, fm = gid * WGM, gsz = (nM - fm) < WGM ? (nM - fm) : WGM;
        u.pm = fm + ((wgid % nig) % gsz); u.pn = (wgid % nig) / gsz; return true;
    }
};

template <class Epi, bool ALIGN_EPI>
__device__ __forceinline__ void gemm_phase(LAS unsigned char* lds, const Gemm g, const Sched& S, const Epi& E, int tid_in) {
    int tid_ = tid_in; asm volatile("" : "+v"(tid_));
    const int tid = tid_, wid = __builtin_amdgcn_readfirstlane(tid >> 6), lane = tid & 63, wr = wid >> 2, wc = wid & 3, fr = lane & 15, fq = lane >> 4;
    const int K = g.K, nt = K / BK;
    unsigned voffA[2], voffB[2];
#pragma unroll
    for (int i = 0; i < 2; ++i) { int R, C; stage_rc(tid * 16 + i * 8192, R, C); const int Rb = (R & ~31) + perm32(R & 31);
        voffA[i] = (unsigned)(R * g.lda + C) * 2u; voffB[i] = (unsigned)(Rb * g.ldb + C) * 2u; }
    const size_t kstep = (size_t)(BK * 2);
    const size_t hsA = (size_t)HALF * g.lda * 2, hsB = (size_t)HALF * g.ldb * 2;
    const size_t tsA = 2 * hsA, tsB = 2 * hsB;
    const unsigned ldsw = (unsigned)wid * 1024u;
    const int aoff = lds_byte(wr * 64 + fr, fq * 8), boff = lds_byte(wc * 32 + fr, fq * 8);
#define PG8_SA(b, h) (((b) * 2 + (h)) * HTB)
#define PG8_SB(b, h) ((4 + (b) * 2 + (h)) * HTB)
#define PG8_STAGE(bufoff, gbase, voff) do { _Pragma("unroll") for (int _i = 0; _i < 2; ++_i) \
        __builtin_amdgcn_global_load_lds((const unsigned*)((const char*)(gbase) + (voff)[_i]), (LAS unsigned*)(lds + (bufoff) + ldsw + _i * 8192), 16, 0, 0); } while (0)
#define PG8_LDA(dst, b, h) do { _Pragma("unroll") for (int m = 0; m < 4; ++m) _Pragma("unroll") for (int k = 0; k < 2; ++k) dst[m][k] = *(const LAS bf16x8*)(lds + PG8_SA(b, h) + aoff + m * 2048 + k * 1024); } while (0)
#define PG8_LDB(dst, b, h) do { _Pragma("unroll") for (int n = 0; n < 2; ++n) _Pragma("unroll") for (int k = 0; k < 2; ++k) dst[n][k] = *(const LAS bf16x8*)(lds + PG8_SB(b, h) + boff + n * 2048 + k * 1024); } while (0)
#define PG8_MMA(ai, bj, At, Bt) do { __builtin_amdgcn_s_setprio(1); _Pragma("unroll") for (int m = 0; m < 4; ++m) _Pragma("unroll") for (int n = 0; n < 2; ++n) _Pragma("unroll") for (int k = 0; k < 2; ++k) \
        acc[ai][bj][m][n] = __builtin_amdgcn_mfma_f32_16x16x32_bf16(Bt[n][k], At[m][k], acc[ai][bj][m][n], 0, 0, 0); __builtin_amdgcn_s_setprio(0); } while (0)
#define PG8_WAIT_V(n) asm volatile("s_waitcnt vmcnt(" #n ")" ::: "memory")
#define PG8_WAIT_L(n) asm volatile("s_waitcnt lgkmcnt(" #n ")" ::: "memory")
#define PG8_BAR __builtin_amdgcn_s_barrier()
#define PG8_SCHED __builtin_amdgcn_sched_barrier(0)
    Unit cur, nxt; int ui = 0;
    if (!S.next(0, cur)) return;
    f32x4 acc[2][2][4][2];
#pragma unroll
    for (int a = 0; a < 2; ++a)
#pragma unroll
        for (int b = 0; b < 2; ++b)
#pragma unroll
            for (int m = 0; m < 4; ++m)
#pragma unroll
                for (int n = 0; n < 2; ++n) acc[a][b][m][n] = (f32x4){0.f, 0.f, 0.f, 0.f};
    bf16x8 At[4][2], B0[2][2], B1[2][2];
    const char* cA = (const char*)(g.A + (size_t)cur.pg * g.gsA) + (size_t)cur.pm * tsA;
    const char* cB = (const char*)(g.Bt + (size_t)cur.pg * g.gsB) + (size_t)cur.pn * tsB;
    PG8_STAGE(PG8_SB(0, 0), cB, voffB); PG8_STAGE(PG8_SB(0, 1), cB + hsB, voffB); PG8_STAGE(PG8_SA(0, 0), cA, voffA); PG8_STAGE(PG8_SA(0, 1), cA + hsA, voffA);
    if (wr == 1) PG8_BAR;
    PG8_WAIT_V(2); PG8_BAR;
    PG8_STAGE(PG8_SB(1, 0), cB + kstep, voffB); PG8_STAGE(PG8_SA(1, 0), cA + kstep, voffA); PG8_STAGE(PG8_SB(1, 1), cB + hsB + kstep, voffB);
    PG8_WAIT_V(6); PG8_BAR;
    for (;;) {
        const bool has_next = S.next(ui + 1, nxt);
        const char* nA = has_next ? (const char*)(g.A + (size_t)nxt.pg * g.gsA) + (size_t)nxt.pm * tsA : cA;
        const char* nB = has_next ? (const char*)(g.Bt + (size_t)nxt.pg * g.gsB) + (size_t)nxt.pn * tsB : cB;
        for (int t = 0; t < nt; t += 2) {
            const bool last = (t == nt - 2);
            const char* a1 = cA + (size_t)(t + 1) * kstep;
            const char* a2 = last ? nA : cA + (size_t)(t + 2) * kstep; const char* b2 = last ? nB : cB + (size_t)(t + 2) * kstep;
            const char* a3 = a2 + kstep; const char* b3 = b2 + kstep;
            PG8_LDB(B0, 0, 0); PG8_LDB(B1, 0, 1); PG8_SCHED; PG8_LDA(At, 0, 0); PG8_STAGE(PG8_SA(1, 1), a1 + hsA, voffA);
            PG8_WAIT_V(8); PG8_WAIT_L(0); PG8_BAR; PG8_MMA(0, 0, At, B0); PG8_MMA(0, 1, At, B1); PG8_BAR; PG8_SCHED;
            PG8_LDA(At, 0, 1); PG8_STAGE(PG8_SB(0, 0), b2, voffB); PG8_STAGE(PG8_SB(0, 1), b2 + hsB, voffB); PG8_STAGE(PG8_SA(0, 0), a2, voffA);
            PG8_WAIT_V(8); PG8_WAIT_L(0); PG8_BAR; PG8_MMA(1, 0, At, B0); PG8_MMA(1, 1, At, B1); PG8_BAR; PG8_SCHED;
            PG8_LDB(B0, 1, 0); PG8_LDB(B1, 1, 1); PG8_SCHED; PG8_LDA(At, 1, 0); PG8_STAGE(PG8_SA(0, 1), a2 + hsA, voffA);
            PG8_WAIT_V(8); PG8_WAIT_L(0); PG8_BAR; PG8_MMA(0, 0, At, B0); PG8_MMA(0, 1, At, B1); PG8_BAR; PG8_SCHED;
            PG8_LDA(At, 1, 1); PG8_STAGE(PG8_SB(1, 0), b3, voffB); PG8_STAGE(PG8_SB(1, 1), b3 + hsB, voffB); PG8_STAGE(PG8_SA(1, 0), a3, voffA);
            PG8_WAIT_V(8); PG8_WAIT_L(0); PG8_BAR; PG8_MMA(1, 0, At, B0); PG8_MMA(1, 1, At, B1); PG8_BAR; PG8_SCHED;
        }
        if constexpr (ALIGN_EPI) { if (wr == 0) PG8_BAR; }
        E(acc, cur, wr, wc, fr, fq);
        if (!has_next) break;
#pragma unroll
        for (int a = 0; a < 2; ++a)
#pragma unroll
            for (int b = 0; b < 2; ++b)
#pragma unroll
                for (int m = 0; m < 4; ++m)
#pragma unroll
                    for (int n = 0; n < 2; ++n) acc[a][b][m][n] = (f32x4){0.f, 0.f, 0.f, 0.f};
        cur = nxt; cA = nA; cB = nB; ++ui;
        if constexpr (ALIGN_EPI) { if (wr == 1) PG8_BAR; }
    }
    PG8_WAIT_V(0);
    if constexpr (!ALIGN_EPI) { if (wr == 0) PG8_BAR; }
    PG8_BAR;
#undef PG8_SA
#undef PG8_SB
#undef PG8_STAGE
#undef PG8_LDA
#undef PG8_LDB
#undef PG8_MMA
#undef PG8_WAIT_V
#undef PG8_WAIT_L
#undef PG8_BAR
#undef PG8_SCHED
}

struct RowScale {
    const float* slots; int s0, npf; float inv_n;
    __device__ __forceinline__ float get(int row, int fq) const {
        const float* p = slots + (size_t)row * 32 + s0 + fq * npf; float s = 0.f;
        for (int i = 0; i < npf; ++i) s += p[i];
        s += __shfl_xor(s, 16); s += __shfl_xor(s, 32);
        return rsqrtf(s * inv_n + EPS);
    }
};
__device__ __forceinline__ float ssq8(const f32x4& a, const f32x4& b) { return (a[0] * a[0] + a[1] * a[1]) + (a[2] * a[2] + a[3] * a[3]) + (b[0] * b[0] + b[1] * b[1]) + (b[2] * b[2] + b[3] * b[3]); }
__device__ __forceinline__ u32x4 pack8(const f32x4& a, const f32x4& b) { u32x4 w; w.x = cvtpk(a[0], a[1]); w.y = cvtpk(a[2], a[3]); w.z = cvtpk(b[0], b[1]); w.w = cvtpk(b[2], b[3]); return w; }

template <int MODE, bool SSQ> struct EpiScaleBf16 {
    bf16_t* O; int ldc; RowScale rs; float* ssq;
    __device__ __forceinline__ void operator()(const f32x4 (&acc)[2][2][4][2], const Unit& u, int wr, int wc, int fr, int fq) const {
        { const int l_ = lane_id_opq(); fr = l_ & 15; fq = l_ >> 4; }
        const int row0 = u.pm * BM + wr * 64 + fr, colb = u.pn * BM + wc * 32 + 8 * fq;
#pragma unroll
        for (int ai = 0; ai < 2; ++ai)
#pragma unroll
            for (int m = 0; m < 4; ++m) { const int row = row0 + ai * HALF + m * 16; const float r = rs.get(row, fq);
#pragma unroll
                for (int bj = 0; bj < 2; ++bj) { const int col = colb + bj * HALF; const f32x4 v0 = acc[ai][bj][m][0] * r, v1 = acc[ai][bj][m][1] * r;
                    bf16_t* p = (MODE == 0) ? O + (size_t)row * ldc + col : O + ((size_t)(col >> 4) * 512 + (row >> 4)) * 384 + (row & 15) * 16 + (col & 15);
                    *(u32x4*)p = pack8(v0, v1);
                    if (SSQ) { float s = ssq8(v0, v1); s += __shfl_xor(s, 16); s += __shfl_xor(s, 32); if (fq == 0) ssq[(size_t)row * 32 + (u.pn * 2 + bj) * 4 + wc] = s; } }
                asm volatile("" ::: "memory"); }
    }
};
template <bool GLU> struct EpiRes {
    float* xout; bf16_t* xb; float* ssq; bool wf32;
    __device__ __forceinline__ void operator()(const f32x4 (&acc)[2][2][4][2], const Unit& u, int wr, int wc, int fr, int fq) const {
        { const int l_ = lane_id_opq(); fr = l_ & 15; fq = l_ >> 4; }
        const int row0 = u.pm * BM + wr * 64 + fr;
#pragma unroll
        for (int ai = 0; ai < 2; ++ai)
#pragma unroll
            for (int m = 0; m < 4; ++m) { const int row = row0 + ai * HALF + m * 16;
#pragma unroll
                for (int bj = 0; bj < (GLU ? 1 : 2); ++bj) { f32x4 v0, v1; int col, slot;
                    if (GLU) { col = u.pn * HALF + wc * 32 + 8 * fq; slot = u.pn * 4 + wc;
#pragma unroll
                        for (int e = 0; e < 4; ++e) { v0[e] = acc[ai][0][m][0][e] * sigmoidf_(acc[ai][1][m][0][e]); v1[e] = acc[ai][0][m][1][e] * sigmoidf_(acc[ai][1][m][1][e]); }
                    } else { col = u.pn * BM + bj * HALF + wc * 32 + 8 * fq; slot = (u.pn * 2 + bj) * 4 + wc; v0 = acc[ai][bj][m][0]; v1 = acc[ai][bj][m][1]; }
                    const size_t p = (size_t)row * DM + col; const u32x4 xw = *(const u32x4*)(xb + p);
                    const f32x4 x0 = (f32x4){bflo(xw.x), bfhi(xw.x), bflo(xw.y), bfhi(xw.y)} + v0, x1 = (f32x4){bflo(xw.z), bfhi(xw.z), bflo(xw.w), bfhi(xw.w)} + v1;
                    if (wf32) { *(f32x4*)(xout + p) = x0; *(f32x4*)(xout + p + 4) = x1; }
                    *(u32x4*)(xb + p) = pack8(x0, x1);
                    float s = ssq8(x0, x1); s += __shfl_xor(s, 16); s += __shfl_xor(s, 32); if (fq == 0) ssq[(size_t)row * 32 + slot] = s; }
                asm volatile("" ::: "memory"); }
    }
};
struct EpiSwiGLU {
    bf16_t* O; RowScale rs;
    __device__ __forceinline__ void operator()(const f32x4 (&acc)[2][2][4][2], const Unit& u, int wr, int wc, int fr, int fq) const {
        { const int l_ = lane_id_opq(); fr = l_ & 15; fq = l_ >> 4; }
        const int row0 = u.pm * BM + wr * 64 + fr, col = u.pn * HALF + wc * 32 + 8 * fq;
#pragma unroll
        for (int ai = 0; ai < 2; ++ai)
#pragma unroll
            for (int m = 0; m < 4; ++m) { const int row = row0 + ai * HALF + m * 16; const float r = rs.get(row, fq); f32x4 v0, v1;
#pragma unroll
                for (int e = 0; e < 4; ++e) { const float g0 = acc[ai][0][m][0][e] * r, g1 = acc[ai][0][m][1][e] * r;
                    v0[e] = g0 * sigmoidf_(g0) * (acc[ai][1][m][0][e] * r); v1[e] = g1 * sigmoidf_(g1) * (acc[ai][1][m][1][e] * r); }
                *(u32x4*)(O + (size_t)row * FF + col) = pack8(v0, v1); asm volatile("" ::: "memory"); }
    }
};
struct EpiSsmP {
    float* W;
    __device__ __forceinline__ void operator()(const f32x4 (&acc)[2][2][4][2], const Unit& u, int wr, int wc, int fr, int fq) const {
        { const int l_ = lane_id_opq(); fr = l_ & 15; fq = l_ >> 4; }
        const int row0 = u.pm * BM + wr * 64 + fr;
#pragma unroll
        for (int ai = 0; ai < 2; ++ai)
#pragma unroll
            for (int m = 0; m < 4; ++m) { const int row = row0 + ai * HALF + m * 16; float* p = W + ((size_t)u.pg * 512 + row) * 128 + wc * 32 + 8 * fq;
                *(f32x4*)p = acc[ai][0][m][0]; *(f32x4*)(p + 4) = acc[ai][0][m][1]; }
    }
};
struct EpiSsmY {
    const bf16_t* Ag; const float* dskip; bf16_t* z;
    __device__ __forceinline__ void operator()(const f32x4 (&acc)[2][2][4][2], const Unit& u, int wr, int wc, int fr, int fq) const {
        { const int l_ = lane_id_opq(); fr = l_ & 15; fq = l_ >> 4; }
        const int row0 = u.pm * BM + wr * 64 + fr, k0 = (fq & 1) * 8;
#pragma unroll
        for (int ai = 0; ai < 2; ++ai)
#pragma unroll
            for (int m = 0; m < 4; ++m) { const int row = row0 + ai * HALF + m * 16;
#pragma unroll
                for (int bj = 0; bj < 2; ++bj) { const int col = bj * HALF + wc * 32 + 8 * fq, t = col >> 4;
                    const u32x4 uw = *(const u32x4*)(Ag + ((size_t)u.pg * 512 + row) * 384 + col);
                    const f32x4 d0 = *(const f32x4*)(dskip + u.pg * 16 + k0), d1 = *(const f32x4*)(dskip + u.pg * 16 + k0 + 4);
                    f32x4 y0 = acc[ai][bj][m][0], y1 = acc[ai][bj][m][1];
                    y0[0] += d0[0] * bflo(uw.x); y0[1] += d0[1] * bfhi(uw.x); y0[2] += d0[2] * bflo(uw.y); y0[3] += d0[3] * bfhi(uw.y);
                    y1[0] += d1[0] * bflo(uw.z); y1[1] += d1[1] * bfhi(uw.z); y1[2] += d1[2] * bflo(uw.w); y1[3] += d1[3] * bfhi(uw.w);
#pragma unroll
                    for (int e = 0; e < 4; ++e) { y0[e] = gelu_tanh(y0[e]); y1[e] = gelu_tanh(y1[e]); }
                    *(u32x4*)(z + ((size_t)row * 16 + t) * DM + u.pg * 16 + k0) = pack8(y0, y1); asm volatile("" ::: "memory"); } }
    }
};
struct EpiHead {
    bf16_t* O; RowScale rs; const float* gn; const float* gr; const float* rc; const float* rsn; float osc; int pitch, hs;
    __device__ __forceinline__ void operator()(const f32x4 (&acc)[2][2][4][2], const Unit& u, int wr, int wc, int fr, int fq) const {
        { const int l_ = lane_id_opq(); fr = l_ & 15; fq = l_ >> 4; }
        const int row0 = u.pm * BM + wr * 64 + fr;
        if (u.pn < 4) { const int h = 4 * u.pn + wc;
#pragma unroll
            for (int ai = 0; ai < 2; ++ai)
#pragma unroll
                for (int m = 0; m < 4; ++m) { const int row = row0 + ai * HALF + m * 16; const float r = rs.get(row, fq);
                    const f32x4 a0 = acc[ai][0][m][0] * r, a1 = acc[ai][0][m][1] * r, b0 = acc[ai][1][m][0] * r, b1 = acc[ai][1][m][1] * r;
                    float s = ssq8(a0, a1) + ssq8(b0, b1); s += __shfl_xor(s, 16); s += __shfl_xor(s, 32);
                    const float rh = rsqrtf(s * (1.0f / 64) + EPS) * osc;
                    bf16_t* p = O + (size_t)row * pitch + h * hs + 8 * fq;
                    { const f32x4 g0 = *(const f32x4*)(gn + 8 * fq), g1 = *(const f32x4*)(gn + 8 * fq + 4); *(u32x4*)p = pack8(a0 * g0 * rh, a1 * g1 * rh); }
                    { const f32x4 g0 = *(const f32x4*)(gn + 32 + 8 * fq), g1 = *(const f32x4*)(gn + 32 + 8 * fq + 4); *(u32x4*)(p + 32) = pack8(b0 * g0 * rh, b1 * g1 * rh); }
                    asm volatile("" ::: "memory"); }
        } else { const int h = 8 * (u.pn - 4) + 2 * wc + (fq >> 1), i0 = (fq & 1) * 8;
#pragma unroll
            for (int ai = 0; ai < 2; ++ai)
#pragma unroll
                for (int m = 0; m < 4; ++m) { const int row = row0 + ai * HALF + m * 16; const float r = rs.get(row, fq);
                    f32x4 x1a = acc[ai][0][m][0] * r, x1b = acc[ai][0][m][1] * r, x2a = acc[ai][1][m][0] * r, x2b = acc[ai][1][m][1] * r;
                    float s = ssq8(x1a, x1b) + ssq8(x2a, x2b); s += __shfl_xor(s, 16);
                    const float rh = rsqrtf(s * (1.0f / 32) + EPS);
                    x1a = x1a * *(const f32x4*)(gr + i0) * rh; x1b = x1b * *(const f32x4*)(gr + i0 + 4) * rh; x2a = x2a * *(const f32x4*)(gr + 16 + i0) * rh; x2b = x2b * *(const f32x4*)(gr + 16 + i0 + 4) * rh;
                    const f32x4 ca = *(const f32x4*)(rc + (size_t)row * 16 + i0) * osc, cb = *(const f32x4*)(rc + (size_t)row * 16 + i0 + 4) * osc, sa = *(const f32x4*)(rsn + (size_t)row * 16 + i0) * osc, sb = *(const f32x4*)(rsn + (size_t)row * 16 + i0 + 4) * osc;
                    bf16_t* p = O + (size_t)row * pitch + h * hs + 64 + i0;
                    *(u32x4*)p = pack8(x1a * ca - x2a * sa, x1b * cb - x2b * sb);
                    *(u32x4*)(p + 16) = pack8(x1a * sa + x2a * ca, x1b * sb + x2b * cb);
                    asm volatile("" ::: "memory"); }
        }
    }
};
struct EpiVt {
    bf16_t* Vt; const float* slots2;
    __device__ __forceinline__ void operator()(const f32x4 (&acc)[2][2][4][2], const Unit& u, int wr, int wc, int fr, int fq) const {
        { const int l_ = lane_id_opq(); fr = l_ & 15; fq = l_ >> 4; }
        const int row0 = u.pm * BM + wr * 64 + fr;
#pragma unroll
        for (int bj = 0; bj < 2; ++bj) { const int tok0 = u.pn * BM + bj * HALF + wc * 32 + 8 * fq, b = tok0 >> 11, l = tok0 & 2047;
            float rt[8];
#pragma unroll
            for (int e = 0; e < 8; ++e) { const float* p = slots2 + (size_t)(tok0 + e) * 32 + 12; const f32x4 a = *(const f32x4*)p, b2 = *(const f32x4*)(p + 4);
                rt[e] = rsqrtf(((a[0] + a[1]) + (a[2] + a[3]) + (b2[0] + b2[1]) + (b2[2] + b2[3])) * (1.0f / 256) + EPS);
                if ((e & 1) == 1) asm volatile("" ::: "memory"); }
#pragma unroll
            for (int ai = 0; ai < 2; ++ai)
#pragma unroll
                for (int m = 0; m < 4; ++m) { const int row = row0 + ai * HALF + m * 16;
                    f32x4 v0 = acc[ai][bj][m][0], v1 = acc[ai][bj][m][1];
#pragma unroll
                    for (int e = 0; e < 4; ++e) { v0[e] *= rt[e]; v1[e] *= rt[4 + e]; }
                    *(u32x4*)(Vt + ((size_t)(b * 1024 + row)) * SEQ + l) = pack8(v0, v1); }
            asm volatile("" ::: "memory"); }
    }
};
}

struct Args { const float* in[N_IN]; float* out; unsigned char* ws; int ph_lo, ph_hi; };

__device__ __forceinline__ void sincos_rev(double rev, float& sn, float& cs) {
    const double fr = rev - rint(rev); const double q = rint(4.0 * fr); const double y = fr - 0.25 * q; const double x = 6.283185307179586 * y, x2 = x * x;
    const double s = x * (1.0 + x2 * (-1.0 / 6 + x2 * (1.0 / 120 + x2 * (-1.0 / 5040 + x2 * (1.0 / 362880 + x2 * (-1.0 / 39916800 + x2 * (1.0 / 6227020800.0)))))));
    const double c = 1.0 + x2 * (-0.5 + x2 * (1.0 / 24 + x2 * (-1.0 / 720 + x2 * (1.0 / 40320 + x2 * (-1.0 / 3628800 + x2 * (1.0 / 479001600.0 + x2 * (-1.0 / 87178291200.0)))))));
    const int qi = ((int)q) & 3;
    const double ss = (qi == 0) ? s : (qi == 1) ? c : (qi == 2) ? -s : -c;
    const double cc = (qi == 0) ? c : (qi == 1) ? -s : (qi == 2) ? -c : s;
    sn = (float)ss; cs = (float)cc;
}

__device__ __forceinline__ void tr_item(const float* W, int K, int N, const float* gain, bf16_t* dst, int ldk, int mode, int H, int drow0, LAS float* scr, int item, int lane) {
    const int nblk = N / 32, kb = item / nblk, nb = item % nblk, k0 = 64 * kb, n0 = 32 * nb;
    { float v[32];
#pragma unroll
      for (int i = 0; i < 32; ++i) { const int kk = 2 * i + (lane >> 5); v[i] = W[(size_t)(k0 + kk) * N + n0 + (lane & 31)]; }
      if (gain) {
#pragma unroll
          for (int i = 0; i < 32; ++i) v[i] *= gain[k0 + 2 * i + (lane >> 5)]; }
#pragma unroll
      for (int i = 0; i < 32; ++i) scr[(2 * i + (lane >> 5)) * 33 + (lane & 31)] = v[i]; }
    asm volatile("s_waitcnt lgkmcnt(0)" ::: "memory");
    int drow, extra16 = 0;
    if (mode == 0) drow = drow0 + n0;
    else if (mode == 1) { const int half = n0 / H, j = n0 % H; drow = drow0 + (j / 128) * 256 + half * 128 + (j % 128); }
    else if (mode == 2) { const int h = n0 / 128, part = (n0 % 128) / 32;
        drow = (part < 2) ? (h / 4) * 256 + part * 128 + (h % 4) * 32 : 1024 + h * 64 + (part - 2) * 32; }
    else { const int h = n0 / 96, part = (n0 % 96) / 32;
        if (part < 2) drow = (h / 4) * 256 + part * 128 + (h % 4) * 32; else { drow = 1024 + (h / 8) * 256 + ((h % 8) / 2) * 32 + (h % 2) * 16; extra16 = 112; } }
    const int c = lane & 7;
#pragma unroll
    for (int j = 0; j < 4; ++j) { const int n = (lane >> 3) + 8 * j; const LAS float* s = scr + (8 * c) * 33 + n;
        u32x4 o; o.x = cvtpk(s[0 * 33], s[1 * 33]); o.y = cvtpk(s[2 * 33], s[3 * 33]); o.z = cvtpk(s[4 * 33], s[5 * 33]); o.w = cvtpk(s[6 * 33], s[7 * 33]);
        *(u32x4*)(dst + (size_t)(drow + n + (n >= 16 ? extra16 : 0)) * ldk + k0 + 8 * c) = o; }
    asm volatile("s_waitcnt lgkmcnt(0)" ::: "memory");
}

__device__ __forceinline__ void ssm_precompute(const Args& a, LAS unsigned char* lds, int job2, int tid_in) {
    const int tid = opq_v(tid_in), half = job2 >> 7, job = job2 & 127, i = job >> 6, g = job & 63, ig = i * 64 + g;
    LAS float* apr = (LAS float*)lds;
    LAS float* api = apr + 17 * 64;
    LAS float* bbr = api + 17 * 64;
    LAS float* bbi = bbr + 1024;
    LAS float* ccr = bbi + 1024;
    LAS float* cci = ccr + 1024;
    LAS float* kern = cci + 1024;
    const float* lam_re = a.in[I_LRE] + (size_t)ig * 64; const float* lam_im = a.in[I_LIM] + (size_t)ig * 64;
    const double step = exp((double)a.in[I_LSTEP][ig]);
    __syncthreads();
    for (int idx = tid; idx < 17 * 64; idx += 512) { const int d = idx >> 6, n = idx & 63;
        const double lr = (double)lam_re[n], li = (double)lam_im[n];
        const double mag = exp(lr * step * d); float sn, cs; sincos_rev(li * step * d * 0.15915494309189535, sn, cs);
        apr[idx] = (float)(mag * cs); api[idx] = (float)(mag * sn); }
    for (int idx = tid; idx < 1024; idx += 512) { ccr[idx] = a.in[I_CRE][(size_t)ig * 1024 + idx]; cci[idx] = a.in[I_CIM][(size_t)ig * 1024 + idx]; }
    __syncthreads();
    for (int idx = tid; idx < 1024; idx += 512) { const int n = idx >> 4;
        const float lr = lam_re[n], li = lam_im[n], are = apr[64 + n], aim = api[64 + n], den = lr * lr + li * li;
        const float fre = ((are - 1.0f) * lr + aim * li) / den, fim = (aim * lr - (are - 1.0f) * li) / den;
        const float br = a.in[I_BRE][(size_t)ig * 1024 + idx], bi = a.in[I_BIM][(size_t)ig * 1024 + idx];
        bbr[idx] = fre * br - fim * bi; bbi[idx] = fre * bi + fim * br; }
    __syncthreads();
    if (half == 0) {
    { const int k = (tid >> 4) & 15, kp = tid & 15, dh = tid >> 8; float s8[8];
#pragma unroll
      for (int it = 0; it < 8; ++it) s8[it] = 0.f;
      for (int n = 0; n < 64; ++n) { const float br = bbr[n * 16 + kp], bi = bbi[n * 16 + kp], cr = ccr[k * 64 + n], ci = cci[k * 64 + n];
          const float ur = cr * br - ci * bi, ui = cr * bi + ci * br;
#pragma unroll
          for (int it = 0; it < 8; ++it) { const int d = 2 * it + dh; s8[it] += apr[d * 64 + n] * ur - api[d * 64 + n] * ui; } }
#pragma unroll
      for (int it = 0; it < 8; ++it) kern[(2 * it + dh) * 256 + (tid & 255)] = s8[it]; }
    __syncthreads();
    bf16_t* bty = (bf16_t*)(a.ws + WS_BTY) + (size_t)ig * 256 * 384;
    for (int idx = tid; idx < 256 * 384; idx += 512) { const int row = idx / 384, col = idx % 384, t = row >> 4, k = row & 15; float v;
        if (col < 256) { const int j = col >> 4, kp = col & 15; v = (j <= t) ? kern[(t - j) * 256 + k * 16 + kp] : 0.f; }
        else if (col < 320) { const int n = col - 256; v = ccr[k * 64 + n] * apr[(t + 1) * 64 + n] - cci[k * 64 + n] * api[(t + 1) * 64 + n]; }
        else { const int n = col - 320; v = -(ccr[k * 64 + n] * api[(t + 1) * 64 + n] + cci[k * 64 + n] * apr[(t + 1) * 64 + n]); }
        bty[idx] = (bf16_t)(cvtpk(v, 0.f) & 0xffffu); }
    } else {
    bf16_t* btp = (bf16_t*)(a.ws + WS_BTP) + (size_t)ig * 256 * 256;
    for (int idx = tid; idx < 256 * 256; idx += 512) { const int row = idx >> 8, col = idx & 255, j = col >> 4, kp = col & 15; float v = 0.f;
        if (row < 128) { const int n = row & 63; const float pr = apr[(15 - j) * 64 + n], pi = api[(15 - j) * 64 + n], br = bbr[n * 16 + kp], bi = bbi[n * 16 + kp];
            v = (row < 64) ? (pr * br - pi * bi) : (pr * bi + pi * br); }
        btp[idx] = (bf16_t)(cvtpk(v, 0.f) & 0xffffu); }
    float* ac = (float*)(a.ws + WS_AC) + (size_t)ig * 128;
    if (tid < 64) { ac[tid] = apr[16 * 64 + tid]; ac[64 + tid] = api[16 * 64 + tid]; }
    }
    __syncthreads();
}

__device__ __forceinline__ void phase_setup(const Args& a, LAS unsigned char* lds, int tid_in) {
    const int tid = opq_v(tid_in), lane = tid & 63, wave = tid >> 6, G = opq_s(gridDim.x), bx = opq_s(blockIdx.x);
    for (int job = bx; job < 256; job += G) ssm_precompute(a, lds, job, tid_in);
    __syncthreads();
    LAS float* scr = (LAS float*)(lds + wave * 8448);
    const int gw = bx * 8 + wave, NGW = G * 8;
    unsigned char* ws = a.ws;
    constexpr int I_GU = 16 * 176, I_DN = 44 * 32, I_IN = 16 * 32, I_GL = 16 * 64, I_QA = 16 * 12, I_KVA = 16 * 9, I_QB = 6 * 48, I_KVB = 4 * 64, I_O = 16 * 32;
    constexpr int NITEMS = 4 * I_GU + 4 * I_DN + 2 * I_IN + 2 * I_GL + 2 * I_QA + I_KVA + 2 * I_QB + I_KVB + 2 * I_O;
    for (int it = gw; it < NITEMS; it += NGW) {
        int r = it;
        if (r < 4 * I_GU) { const int l = r / I_GU; tr_item(a.in[I_WGU] + (size_t)l * DM * 2 * FF, DM, 2 * FF, a.in[I_FFNN] + l * DM, (bf16_t*)(ws + WS_WGU) + (size_t)l * 2 * FF * DM, DM, 1, FF, 0, scr, r % I_GU, lane); continue; } r -= 4 * I_GU;
        if (r < 4 * I_DN) { const int l = r / I_DN; tr_item(a.in[I_WDN] + (size_t)l * FF * DM, FF, DM, nullptr, (bf16_t*)(ws + WS_WDN) + (size_t)l * DM * FF, FF, 0, 1, 0, scr, r % I_DN, lane); continue; } r -= 4 * I_DN;
        if (r < 2 * I_IN) { const int l = r / I_IN; tr_item(a.in[I_SWIN] + (size_t)l * DM * DM, DM, DM, a.in[I_MIXN] + l * DM, (bf16_t*)(ws + WS_WIN) + (size_t)l * DM * DM, DM, 0, 1, 0, scr, r % I_IN, lane); continue; } r -= 2 * I_IN;
        if (r < 2 * I_GL) { const int l = r / I_GL; tr_item(a.in[I_SGLU] + (size_t)l * DM * 2 * DM, DM, 2 * DM, nullptr, (bf16_t*)(ws + WS_WGLU) + (size_t)l * 2 * DM * DM, DM, 1, DM, 0, scr, r % I_GL, lane); continue; } r -= 2 * I_GL;
        if (r < I_QA) { tr_item(a.in[I_WQA], DM, 384, a.in[I_MIXN] + 2 * DM, (bf16_t*)(ws + WS_WQKVA), DM, 0, 1, 0, scr, r, lane); continue; } r -= I_QA;
        if (r < I_QA) { tr_item(a.in[I_WQA] + (size_t)DM * 384, DM, 384, a.in[I_MIXN] + 3 * DM, (bf16_t*)(ws + WS_WQA3), DM, 0, 1, 0, scr, r, lane); continue; } r -= I_QA;
        if (r < I_KVA) { tr_item(a.in[I_WKVA], DM, 288, a.in[I_KVINN], (bf16_t*)(ws + WS_WQKVA), DM, 0, 1, 384, scr, r, lane); continue; } r -= I_KVA;
        if (r < 2 * I_QB) { const int l = r / I_QB; tr_item(a.in[I_WQB] + (size_t)l * 384 * 1536, 384, 1536, a.in[I_QAN] + l * 384, (bf16_t*)(ws + WS_WQB) + (size_t)l * 1536 * 384, 384, 3, 1, 0, scr, r % I_QB, lane); continue; } r -= 2 * I_QB;
        if (r < I_KVB) { tr_item(a.in[I_WKVB], 256, 2048, a.in[I_KVAN], (bf16_t*)(ws + WS_WKVB), 256, 2, 1, 0, scr, r, lane); continue; } r -= I_KVB;
        { const int l = r / I_O; tr_item(a.in[I_WO] + (size_t)l * DM * DM, DM, DM, nullptr, (bf16_t*)(ws + WS_WO) + (size_t)l * DM * DM, DM, 0, 1, 0, scr, r % I_O, lane); }
    }
    { const int gt = bx * 512 + tid, NT_ = G * 512;
      u32x4* p0 = (u32x4*)((bf16_t*)(ws + WS_WQKVA) + (size_t)672 * DM); for (int i = gt; i < 96 * DM / 8; i += NT_) p0[i] = (u32x4){0u, 0u, 0u, 0u};
      u32x4* p1 = (u32x4*)((bf16_t*)(ws + WS_WQA3) + (size_t)384 * DM); for (int i = gt; i < 128 * DM / 8; i += NT_) p1[i] = (u32x4){0u, 0u, 0u, 0u};
      float* rc = (float*)(ws + WS_ROPE); float* rsn = rc + (size_t)T * 16; const int* pos = (const int*)a.in[I_POS];
      for (int i = gt; i < T * 16; i += NT_) { const int tok = i >> 4, f = i & 15; double inv = 1.0; for (int q = 0; q < f; ++q) inv *= 0.5623413251903491;
          float sn, cs; sincos_rev((double)pos[tok] * inv * 0.15915494309189535, sn, cs); rc[i] = cs; rsn[i] = sn; } }
    { const float* x = a.in[I_X]; bf16_t* xb = (bf16_t*)(ws + WS_XB); float* slots = (float*)(ws + WS_SLOT);
      for (int row0 = gw; row0 < T; row0 += 4 * NGW) { f32x4 v[4][4];
#pragma unroll
          for (int q = 0; q < 4; ++q) { const f32x4* xr = (const f32x4*)(x + (size_t)(row0 + q * NGW) * DM) + lane;
#pragma unroll
              for (int j = 0; j < 4; ++j) v[q][j] = xr[64 * j]; }
#pragma unroll
          for (int q = 0; q < 4; ++q) { const int row = row0 + q * NGW; float s = 0.f;
#pragma unroll
              for (int j = 0; j < 4; ++j) { const f32x4 t = v[q][j]; s += (t[0] * t[0] + t[1] * t[1]) + (t[2] * t[2] + t[3] * t[3]);
                  u32x2 w; w.x = cvtpk(t[0], t[1]); w.y = cvtpk(t[2], t[3]); *((u32x2*)(xb + (size_t)row * DM) + lane + 64 * j) = w; }
              s += __shfl_xor(s, 1); if ((lane & 1) == 0) slots[(size_t)row * 32 + (lane >> 1)] = s; } } }
}

__device__ __forceinline__ void phase_scan(const Args& a, int layer, int tid_in) {
    const int bx_ = opq_s(blockIdx.x), gx = bx_ & 7;
    const float* W = (const float*)(a.ws + loff_(gx, L_WST)); bf16_t* Ag = (bf16_t*)(a.ws + loff_(gx, L_AG)); const float* ac = (const float*)(a.ws + WS_AC) + (size_t)layer * 64 * 128;
    for (int gt = (bx_ >> 3) * 512 + opq_v(tid_in); gt < 4 * 64 * 64; gt += 32 * 512) {
        const int n = gt & 63, g = (gt >> 6) & 63, b = gt >> 12;
        const float ar = ac[g * 128 + n], ai = ac[g * 128 + 64 + n]; float sr = 0.f, si = 0.f;
        const size_t row0 = (size_t)g * 512 + (size_t)b * 128;
        const float* w = W + row0 * 128 + n; bf16_t* o = Ag + row0 * 384 + 256 + n;
#pragma unroll 1
        for (int m0 = 0; m0 < 128; m0 += 16) { float wr_[16], wi_[16];
#pragma unroll
            for (int j = 0; j < 16; ++j) { wr_[j] = w[(size_t)(m0 + j) * 128]; wi_[j] = w[(size_t)(m0 + j) * 128 + 64]; }
#pragma unroll
            for (int j = 0; j < 16; ++j) { const int m = m0 + j;
                o[(size_t)m * 384] = (bf16_t)(cvtpk(sr, 0.f) & 0xffffu); o[(size_t)m * 384 + 64] = (bf16_t)(cvtpk(si, 0.f) & 0xffffu);
                const float nr = ar * sr - ai * si + wr_[j], ni = ar * si + ai * sr + wi_[j]; sr = nr; si = ni; } }
    }
}

__device__ __forceinline__ void phase_krope(const Args& a, int tid_in) {
    unsigned char* ws = a.ws;
    const int bx_ = opq_s(blockIdx.x), gx = bx_ & 7;
    const bf16_t* qkva = (const bf16_t*)(ws + voff(gx, L_QKVA, 1536)); const float* slots2 = (const float*)(ws + WS_SLOT2);
    bf16_t* KR = (bf16_t*)(ws + voff(gx, L_KR, 64)); const float* rc = (const float*)(ws + WS_ROPE); const float* rsn = rc + (size_t)T * 16;
    const float* gkr = a.in[I_KROPEN];
    for (int gt = (bx_ >> 3) * 512 + opq_v(tid_in); gt < (int)GTOK * 4; gt += 32 * 512) { const int tok = gx * (int)GTOK + (gt >> 2), qd = gt & 3;
        const u32x2 w1 = *(const u32x2*)(qkva + (size_t)tok * 768 + 640 + 4 * qd), w2 = *(const u32x2*)(qkva + (size_t)tok * 768 + 656 + 4 * qd);
        const float r = rsqrtf(slots2[(size_t)tok * 32 + 20] * (1.0f / 32) + EPS);
        const float x1[4] = {bflo(w1.x), bfhi(w1.x), bflo(w1.y), bfhi(w1.y)}, x2[4] = {bflo(w2.x), bfhi(w2.x), bflo(w2.y), bfhi(w2.y)}; float o1[4], o2[4];
#pragma unroll
        for (int e = 0; e < 4; ++e) { const int i = 4 * qd + e; const float a1 = x1[e] * r * gkr[i], a2 = x2[e] * r * gkr[16 + i], c = rc[(size_t)tok * 16 + i], s = rsn[(size_t)tok * 16 + i];
            o1[e] = a1 * c - a2 * s; o2[e] = a1 * s + a2 * c; }
        u32x2 p1, p2; p1.x = cvtpk(o1[0], o1[1]); p1.y = cvtpk(o1[2], o1[3]); p2.x = cvtpk(o2[0], o2[1]); p2.y = cvtpk(o2[2], o2[3]);
        *(u32x2*)(KR + (size_t)tok * 32 + 4 * qd) = p1; *(u32x2*)(KR + (size_t)tok * 32 + 16 + 4 * qd) = p2; }
}

__device__ __forceinline__ int crow(int r, int hi) { return (r & 3) + 8 * (r >> 2) + 4 * hi; }
constexpr int AT_KROW = 208, AT_KBUF = 64 * AT_KROW, AT_VROW = 136, AT_VBUF = 64 * AT_VROW, AT_VOFF = 2 * AT_KBUF;
template <bool FIXED>
__device__ __forceinline__ void attn_unit(LAS unsigned char* lds, const bf16_t* Q, const bf16_t* Kf, const bf16_t* KR, const bf16_t* Vt, bf16_t* O, int b, int h, int qb, int tid_in, float negB) {
    const int tid = opq_v(tid_in), lane = tid & 63, r32 = lane & 31, hi = lane >> 5; const int wid = __builtin_amdgcn_readfirstlane(tid >> 6);
    const int q0 = qb * 256; const size_t rowbase = (size_t)b * SEQ;
    const int qabs = q0 + wid * 32 + r32;
    bf16x8 qf[6];
    { const bf16_t* qp = Q + (rowbase + qabs) * 1536 + h * 96 + hi * 8;
#pragma unroll
      for (int s = 0; s < 6; ++s) qf[s] = *(const bf16x8*)(qp + 16 * s); }
    const int NT_ = (q0 + 256) / 64;
    const int kr0 = tid / 12, kp0 = tid % 12, kr1 = (512 + tid) / 12, kp1 = (512 + tid) % 12; const bool k2 = tid < 256;
    const bf16_t* kg0 = (kp0 < 8) ? Kf + (rowbase + kr0) * 1024 + h * 64 + kp0 * 8 : KR + (rowbase + kr0) * 32 + (kp0 - 8) * 8;
    const bf16_t* kg1 = (kp1 < 8) ? Kf + (rowbase + kr1) * 1024 + h * 64 + kp1 * 8 : KR + (rowbase + kr1) * 32 + (kp1 - 8) * 8;
    const size_t ks0 = (kp0 < 8) ? (size_t)64 * 1024 : (size_t)64 * 32, ks1 = (kp1 < 8) ? (size_t)64 * 1024 : (size_t)64 * 32;
    const int kl0 = kr0 * AT_KROW + kp0 * 16, kl1 = kr1 * AT_KROW + kp1 * 16;
    const int vd = tid >> 3, vp = tid & 7;
    const bf16_t* vg = Vt + ((size_t)(b * NH + h) * 64 + vd) * SEQ + vp * 8;
    const int vl = AT_VOFF + vd * AT_VROW + vp * 16;
    u32x4 kreg0, kreg1 = (u32x4){0u, 0u, 0u, 0u}, vreg;
    kreg0 = *(const u32x4*)kg0; if (k2) kreg1 = *(const u32x4*)kg1; vreg = *(const u32x4*)vg;
    *(LAS u32x4*)(lds + kl0) = kreg0; if (k2) *(LAS u32x4*)(lds + kl1) = kreg1;
    *(LAS u32x2*)(lds + vl) = (u32x2){vreg.x, vreg.y}; *(LAS u32x2*)(lds + vl + 8) = (u32x2){vreg.z, vreg.w};
    __syncthreads();
    float m_run = -1e30f, l_run = 0.f; f32x16 o0, o1, cinit;
#pragma unroll
    for (int r = 0; r < 16; ++r) { o0[r] = 0.f; o1[r] = 0.f; cinit[r] = FIXED ? negB : 0.f; }
    for (int t = 0; t < NT_; ++t) {
        const bool pre = (t + 1 < NT_);
        if (pre) { kreg0 = *(const u32x4*)(kg0 + (size_t)(t + 1) * ks0); if (k2) kreg1 = *(const u32x4*)(kg1 + (size_t)(t + 1) * ks1); vreg = *(const u32x4*)(vg + (t + 1) * 64); }
        const int kv0 = t * 64;
        if (kv0 <= q0 + wid * 32 + 31) {
            const LAS unsigned char* kb = lds + (t & 1) * AT_KBUF + r32 * AT_KROW + hi * 16;
            const LAS unsigned char* vb = lds + AT_VOFF + (t & 1) * AT_VBUF + r32 * AT_VROW + hi * 8;
            f32x16 s0, s1;
            { bf16x8 kf[12];
#pragma unroll
              for (int s = 0; s < 6; ++s) { kf[2 * s] = *(const LAS bf16x8*)(kb + s * 32); kf[2 * s + 1] = *(const LAS bf16x8*)(kb + 32 * AT_KROW + s * 32); }
              asm volatile("s_waitcnt lgkmcnt(0)" ::: "memory"); __builtin_amdgcn_sched_barrier(0);
#pragma unroll
              for (int s = 0; s < 6; ++s) { s0 = __builtin_amdgcn_mfma_f32_32x32x16_bf16(kf[2 * s], qf[s], s == 0 ? cinit : s0, 0, 0, 0); s1 = __builtin_amdgcn_mfma_f32_32x32x16_bf16(kf[2 * s + 1], qf[s], s == 0 ? cinit : s1, 0, 0, 0); } }
            __builtin_amdgcn_sched_barrier(0);
            u32x2 vf[16];
#pragma unroll
            for (int s = 0; s < 4; ++s) { vf[4 * s] = *(const LAS u32x2*)(vb + s * 32); vf[4 * s + 1] = *(const LAS u32x2*)(vb + s * 32 + 16);
                vf[4 * s + 2] = *(const LAS u32x2*)(vb + 32 * AT_VROW + s * 32); vf[4 * s + 3] = *(const LAS u32x2*)(vb + 32 * AT_VROW + s * 32 + 16); }
            if (kv0 + 63 > q0 + wid * 32) {
#pragma unroll
                for (int r = 0; r < 16; ++r) { const int kv = kv0 + crow(r, hi); if (kv > qabs) s0[r] = -1e30f; if (kv + 32 > qabs) s1[r] = -1e30f; }
            }
            if (FIXED) {
                float ps = 0.f;
#pragma unroll
                for (int r = 0; r < 16; ++r) { s0[r] = __builtin_amdgcn_exp2f(s0[r]); s1[r] = __builtin_amdgcn_exp2f(s1[r]); ps += s0[r] + s1[r]; }
                l_run += ps;
            } else {
                float mx = fmaxf(s0[0], s1[0]);
#pragma unroll
                for (int r = 1; r < 16; ++r) mx = fmaxf(mx, fmaxf(s0[r], s1[r]));
                mx = fmaxf(mx, __shfl_xor(mx, 32));
                const float m_new = fmaxf(m_run, mx), alpha = __builtin_amdgcn_exp2f(m_run - m_new); m_run = m_new;
                float ps = 0.f;
#pragma unroll
                for (int r = 0; r < 16; ++r) { s0[r] = __builtin_amdgcn_exp2f(s0[r] - m_new); s1[r] = __builtin_amdgcn_exp2f(s1[r] - m_new); ps += s0[r] + s1[r]; }
                l_run = l_run * alpha + ps;
#pragma unroll
                for (int r = 0; r < 16; ++r) { o0[r] *= alpha; o1[r] *= alpha; }
            }
            bf16x8 pk[4];
#pragma unroll
            for (int s = 0; s < 4; ++s) { u32x4 w;
#pragma unroll
                for (int e = 0; e < 4; ++e) { const int r = 8 * (s & 1) + 2 * e; w[e] = (s < 2) ? cvtpk(s0[r], s0[r + 1]) : cvtpk(s1[r], s1[r + 1]); }
                pk[s] = __builtin_bit_cast(bf16x8, w); }
            asm volatile("s_waitcnt lgkmcnt(0)" ::: "memory"); __builtin_amdgcn_sched_barrier(0);
#pragma unroll
            for (int s = 0; s < 4; ++s) {
                { const u32x4 w = (u32x4){vf[4 * s].x, vf[4 * s].y, vf[4 * s + 1].x, vf[4 * s + 1].y}; o0 = __builtin_amdgcn_mfma_f32_32x32x16_bf16(__builtin_bit_cast(bf16x8, w), pk[s], o0, 0, 0, 0); }
                { const u32x4 w = (u32x4){vf[4 * s + 2].x, vf[4 * s + 2].y, vf[4 * s + 3].x, vf[4 * s + 3].y}; o1 = __builtin_amdgcn_mfma_f32_32x32x16_bf16(__builtin_bit_cast(bf16x8, w), pk[s], o1, 0, 0, 0); }
            }
        }
        if (pre) { const int bo = ((t + 1) & 1); *(LAS u32x4*)(lds + bo * AT_KBUF + kl0) = kreg0; if (k2) *(LAS u32x4*)(lds + bo * AT_KBUF + kl1) = kreg1;
            *(LAS u32x2*)(lds + bo * AT_VBUF + vl) = (u32x2){vreg.x, vreg.y}; *(LAS u32x2*)(lds + bo * AT_VBUF + vl + 8) = (u32x2){vreg.z, vreg.w}; }
        __syncthreads();
    }
    const float lt = l_run + __shfl_xor(l_run, 32), inv = 1.0f / lt;
    bf16_t* op = O + (rowbase + qabs) * DM + h * 64 + 4 * hi;
#pragma unroll
    for (int g = 0; g < 4; ++g) { u32x2 w; w.x = cvtpk(o0[4 * g] * inv, o0[4 * g + 1] * inv); w.y = cvtpk(o0[4 * g + 2] * inv, o0[4 * g + 3] * inv); *(u32x2*)(op + 8 * g) = w;
        u32x2 w2; w2.x = cvtpk(o1[4 * g] * inv, o1[4 * g + 1] * inv); w2.y = cvtpk(o1[4 * g + 2] * inv, o1[4 * g + 3] * inv); *(u32x2*)(op + 32 + 8 * g) = w2; }
}
__device__ __forceinline__ float wave_max(float v) {
#pragma unroll
    for (int o = 1; o < 64; o <<= 1) v = fmaxf(v, __shfl_xor(v, o));
    return v;
}
__device__ __forceinline__ void phase_attn(const Args& a, LAS unsigned char* lds, int tid_in, int j) {
    const int gx_ = opq_s(blockIdx.x) & 7;
    const bf16_t* Q = (const bf16_t*)(a.ws + voff(gx_, L_QRAW, 3072)); const bf16_t* Kf = (const bf16_t*)(a.ws + voff(gx_, L_KF, 2048)); const bf16_t* KR = (const bf16_t*)(a.ws + voff(gx_, L_KR, 64)); const bf16_t* Vt = (const bf16_t*)(a.ws + voff(gx_, L_VT, 2048)); bf16_t* O = (bf16_t*)(a.ws + voff(gx_, L_O, 2048));
    float B;
    { const int lane = opq_v(tid_in) & 63;
      const float gqn = wave_max(fabsf(a.in[I_QNOPEN][j * 64 + lane])), gkn = wave_max(fabsf(a.in[I_KNOPEN][lane]));
      const float gqr = wave_max(fabsf(a.in[I_QROPEN][j * 32 + (lane & 31)])), gkr = wave_max(fabsf(a.in[I_KROPEN][lane & 31]));
      B = sqrtf(64.f * gqn * gqn + 32.f * gqr * gqr) * sqrtf(64.f * gkn * gkn + 32.f * gkr * gkr) * QSCALE * 1.02f; }
    const bool fixed = (B <= 40.0f);
    const int bx = opq_s(blockIdx.x); const int vcu = (bx & 7) * 32 + (bx >> 3);
    for (int p = vcu * 8; p < vcu * 8 + 8; ++p) {
        const int bh = p >> 2, s = p & 3;
        if (fixed) { attn_unit<true>(lds, Q, Kf, KR, Vt, O, bh / NH, bh % NH, 7 - s, tid_in, -B); attn_unit<true>(lds, Q, Kf, KR, Vt, O, bh / NH, bh % NH, s, tid_in, -B); }
        else { attn_unit<false>(lds, Q, Kf, KR, Vt, O, bh / NH, bh % NH, 7 - s, tid_in, 0.f); attn_unit<false>(lds, Q, Kf, KR, Vt, O, bh / NH, bh % NH, s, tid_in, 0.f); }
    }
}

#define XB_TMO      128
#define XB_XCNT(j)  (256  + 64 * (j))
#define XB_XSUB(j)  (1280 + 64 * (j))
#define XB_XGEN(j)  (2304 + 64 * (j))
#define XB_TOP      3328
#define XB_TOPGEN   3392
#define XCD_BAR_WORDS 3456
#define XB_SPIN_CAP (1u << 18)

__device__ __forceinline__ unsigned xb_ld(unsigned* p)              { return __hip_atomic_load(p, __ATOMIC_RELAXED, __HIP_MEMORY_SCOPE_AGENT); }
__device__ __forceinline__ unsigned xb_add(unsigned* p, unsigned v) { return __hip_atomic_fetch_add(p, v, __ATOMIC_RELAXED, __HIP_MEMORY_SCOPE_AGENT); }
__device__ __forceinline__ unsigned xb_xcc_id() { return (unsigned)__builtin_amdgcn_s_getreg((3 << 11) | 20) & 0xFu; }
#define XB_SPIN(cond, bar) do { unsigned _sp = 0; while (cond) { __builtin_amdgcn_s_sleep(1); \
    if ((++_sp & 255u) == 0u) { if (xb_ld(&(bar)[XB_TMO])) break; if (_sp > XB_SPIN_CAP) { atomicAdd(&(bar)[XB_TMO], 1u); break; } } } } while (0)

#ifndef GB_SKIP_WB
#define GB_SKIP_WB 1
#endif
struct XcdBarrier {
    unsigned* bar; unsigned x; unsigned gsz;
    volatile LAS unsigned* st;
};

__device__ __forceinline__ XcdBarrier xcd_barrier_post(unsigned* bar, volatile LAS unsigned* st) {
    XcdBarrier b; b.bar = bar; b.x = xb_xcc_id(); b.st = st;
    if (threadIdx.x == 0) (void)xb_add(&bar[XB_XCNT(b.x)], 1u);
    return b;
}
__device__ __forceinline__ void xcd_barrier_complete(unsigned* bar, unsigned x, unsigned& nloc, unsigned& nx, unsigned G) {
    unsigned sum, cnt, mine, sp = 0u;
    for (;;) {
        sum = 0u; cnt = 0u; mine = 0u;
#pragma unroll
        for (unsigned j = 0; j < 16; ++j) { const unsigned c = xb_ld(&bar[XB_XCNT(j)]); sum += c; cnt += (c > 0u) ? 1u : 0u; mine = (j == x) ? c : mine; }
        if (sum == G) break;
        __builtin_amdgcn_s_sleep(1);
        if ((++sp & 255u) == 0u) { if (xb_ld(&bar[XB_TMO])) break; if (sp > XB_SPIN_CAP) { atomicAdd(&bar[XB_TMO], 1u); break; } }
    }
    nloc = mine > 0u ? mine : 1u; nx = cnt > 0u ? cnt : 1u;
}

__device__ __forceinline__ void xcd_barrier(const XcdBarrier& b, int tid_in) {
    asm volatile("s_waitcnt vmcnt(0)" ::: "memory");
    __syncthreads();
    if (tid_in == 0) {
        unsigned* bar = b.bar; asm volatile("" : "+s"(bar));
        __builtin_amdgcn_s_waitcnt(0);
        unsigned nloc = b.st[0], nx = b.st[1];
        if (nloc == 0u) { xcd_barrier_complete(bar, b.x, nloc, nx, b.gsz); b.st[0] = nloc; b.st[1] = nx; }
        const unsigned old = xb_add(&bar[XB_XSUB(b.x)], 1u);
        const unsigned gen = old / nloc;
        if (old + 1u == (gen + 1u) * nloc) {
            if (GB_SKIP_WB == 0 || nx > 1u) {
            __builtin_amdgcn_fence(__ATOMIC_RELEASE, "agent");
            asm volatile("s_waitcnt vmcnt(0)" ::: "memory"); }
            const unsigned og = xb_add(&bar[XB_TOP], 1u);
            const unsigned tg = og / nx;
            if (og + 1u == (tg + 1u) * nx) xb_add(&bar[XB_TOPGEN], 1u);
            else XB_SPIN(xb_ld(&bar[XB_TOPGEN]) == tg, bar);
            __builtin_amdgcn_fence(__ATOMIC_ACQUIRE, "agent");
            xb_add(&bar[XB_XGEN(b.x)], 1u);
            asm volatile("s_waitcnt vmcnt(0)" ::: "memory");
        } else {
            XB_SPIN(xb_ld(&bar[XB_XGEN(b.x)]) == gen, bar);
            __builtin_amdgcn_fence(__ATOMIC_ACQUIRE, "agent");
            asm volatile("s_waitcnt vmcnt(0)" ::: "memory");
        }
    }
    __syncthreads();
}

#ifndef PHMASK
#define PHMASK 0xFFFFFFFFu
#endif
#define EN(k) (((PHMASK) >> (k)) & 1u)
#ifndef REPMASK
#define REPMASK 0u
#endif
#define REP(k) (((REPMASK) >> (k)) & 1u)
constexpr int LDS_BYTES = 131072 + 256;
#if defined(__HIP_DEVICE_COMPILE__)
typedef const __attribute__((address_space(4))) Args* kargs_t;
#else
typedef const Args* kargs_t;
#endif
__device__ __forceinline__ kargs_t args_ptr() {
    unsigned long long v = (unsigned long long)__builtin_amdgcn_kernarg_segment_ptr(); asm volatile("" : "+s"(v)); return (kargs_t)v;
}
__global__ void __launch_bounds__(512, 2) yoco_fwd(Args a0) {
    extern __shared__ __attribute__((aligned(16))) unsigned char lds_raw[];
    LAS unsigned char* lds = (LAS unsigned char*)lds_raw;
    cg::grid_group grid = cg::this_grid();
    const int G = gridDim.x, bx = blockIdx.x;
    const int s_wid = __builtin_amdgcn_readfirstlane((int)threadIdx.x >> 6);
#define TIDV ((s_wid << 6) | lane_id_opq())
    if (threadIdx.x < 64) ((LAS unsigned*)(lds + 131072))[threadIdx.x] = 0u;
    __syncthreads();
    XcdBarrier xbar = xcd_barrier_post((unsigned*)(a0.ws + WS_BAR + (size_t)(bx & 7) * WS_BAR_GRP), (volatile LAS unsigned*)(lds + 131072)); xbar.gsz = 32u;
#define GRID_SYNC() xcd_barrier(xbar, TIDV)
#define PHASE_BEGIN(k) { for (int rep_ = 0; rep_ <= (int)REP(k); ++rep_) { if (rep_) GRID_SYNC(); const Args a = *args_ptr(); unsigned char* ws = a.ws; const int gx = opq_s(bx) & 7; (void)gx; bf16_t* xb = (bf16_t*)(ws + WS_XB); float* slots = (float*)(ws + WS_SLOT); float* slots2 = (float*)(ws + WS_SLOT2); (void)xb; (void)slots; (void)slots2;
#define PHASE_END   } GRID_SYNC(); }
#define PHASE_END_LAST(cond) } if (cond) GRID_SYNC(); }
    using namespace pg8;
#ifdef EXTRA_SYNCS
    for (int i_ = 0; i_ < EXTRA_SYNCS; ++i_) GRID_SYNC();
#endif
    PHASE_BEGIN(0) phase_setup(a, lds, TIDV); } grid.sync(); }
#pragma unroll 1
    for (int layer = 0; layer < 4; ++layer) {
        if (layer < 2) {
            PHASE_BEGIN(1) { Gemm g{xb, (const bf16_t*)(ws + WS_WIN) + (size_t)layer * DM * DM, DM, DM, DM, 0, 0}; Sched S; S.init(T, DM, 1, opq_s(G), opq_s(bx));
                EpiScaleBf16<1, false> E{(bf16_t*)(ws + voff(gx, L_AG, 48)), 0, RowScale{slots, 0, 8, 1.0f / DM}, nullptr}; gemm_phase<EpiScaleBf16<1, false>, true>(lds, g, S, E, TIDV); } PHASE_END
            PHASE_BEGIN(2) { Gemm g{(const bf16_t*)(ws + loff_(gx, L_AG)), (const bf16_t*)(ws + WS_BTP) + (size_t)layer * 64 * 256 * 256, 256, 384, 256, 512L * 384, 256L * 256}; Sched S; S.init_local(1, opq_s(bx));
                EpiSsmP E{(float*)(ws + loff_(gx, L_WST))}; gemm_phase<EpiSsmP, true>(lds, g, S, E, TIDV); } PHASE_END
            PHASE_BEGIN(3) phase_scan(a, layer, TIDV); PHASE_END
            PHASE_BEGIN(4) { Gemm g{(const bf16_t*)(ws + loff_(gx, L_AG)), (const bf16_t*)(ws + WS_BTY) + (size_t)layer * 64 * 256 * 384, 384, 384, 384, 512L * 384, 256L * 384}; Sched S; S.init_local(1, opq_s(bx));
                EpiSsmY E{(const bf16_t*)(ws + loff_(gx, L_AG)), a.in[I_SD] + layer * DM, (bf16_t*)(ws + loff_(gx, L_Z))}; gemm_phase<EpiSsmY, true>(lds, g, S, E, TIDV); } PHASE_END
            PHASE_BEGIN(5) { Gemm g{(const bf16_t*)(ws + voff(gx, L_Z, 2048)), (const bf16_t*)(ws + WS_WGLU) + (size_t)layer * 2 * DM * DM, DM, DM, DM, 0, 0}; Sched S; S.init(T, 2 * DM, 1, opq_s(G), opq_s(bx));
                EpiRes<true> E{a.out, xb, slots, false}; gemm_phase<EpiRes<true>, true>(lds, g, S, E, TIDV); } PHASE_END
        } else {
            const int j = layer - 2;
            if (j == 0) {
                PHASE_BEGIN(6) { Gemm g{xb, (const bf16_t*)(ws + WS_WQKVA), DM, DM, DM, 0, 0}; Sched S; S.init(T, 768, 1, opq_s(G), opq_s(bx));
                    EpiScaleBf16<0, true> E{(bf16_t*)(ws + voff(gx, L_QKVA, 1536)), 768, RowScale{slots, 0, 8, 1.0f / DM}, slots2}; gemm_phase<EpiScaleBf16<0, true>, true>(lds, g, S, E, TIDV); } PHASE_END
                PHASE_BEGIN(7) { phase_krope(a, TIDV);
                    { Gemm g{(const bf16_t*)(ws + voff(gx, L_QKVA, 1536)) + 384, (const bf16_t*)(ws + WS_WKVB), 256, 768, 256, 0, 0}; Sched S; S.init(T, 1024, 1, opq_s(G), opq_s(bx));
                      EpiHead E{(bf16_t*)(ws + voff(gx, L_KF, 2048)), RowScale{slots2, 12, 2, 1.0f / 256}, a.in[I_KNOPEN], nullptr, nullptr, nullptr, 1.0f, 1024, 64}; gemm_phase<EpiHead, true>(lds, g, S, E, TIDV); }
                    { Gemm g{(const bf16_t*)(ws + WS_WKVB) + (size_t)1024 * 256, (const bf16_t*)(ws + voff(gx, L_QKVA, 1536)) + 384, 256, 256, 768, 0, 0}; Sched S; S.init_local(2, opq_s(bx));
                      EpiVt E{(bf16_t*)(ws + voff(gx, L_VT, 2048)), slots2}; gemm_phase<EpiVt, true>(lds, g, S, E, TIDV); }
                    { Gemm g{(const bf16_t*)(ws + voff(gx, L_QKVA, 1536)), (const bf16_t*)(ws + WS_WQB), 384, 768, 384, 0, 0}; Sched S; S.init(T, 1536, 1, opq_s(G), opq_s(bx));
                      EpiHead E{(bf16_t*)(ws + voff(gx, L_QRAW, 3072)), RowScale{slots2, 0, 3, 1.0f / 384}, a.in[I_QNOPEN], a.in[I_QROPEN], (const float*)(ws + WS_ROPE), (const float*)(ws + WS_ROPE) + (size_t)T * 16, QSCALE, 1536, 96}; gemm_phase<EpiHead, true>(lds, g, S, E, TIDV); } } PHASE_END
            } else {
                PHASE_BEGIN(10) { Gemm g{xb, (const bf16_t*)(ws + WS_WQA3), DM, DM, DM, 0, 0}; Sched S; S.init(T, 512, 1, opq_s(G), opq_s(bx));
                    EpiScaleBf16<0, true> E{(bf16_t*)(ws + voff(gx, L_QKVA, 1024)), 512, RowScale{slots, 0, 8, 1.0f / DM}, slots2}; gemm_phase<EpiScaleBf16<0, true>, true>(lds, g, S, E, TIDV); } PHASE_END
                PHASE_BEGIN(11) { Gemm g{(const bf16_t*)(ws + voff(gx, L_QKVA, 1024)), (const bf16_t*)(ws + WS_WQB) + (size_t)1536 * 384, 384, 512, 384, 0, 0}; Sched S; S.init(T, 1536, 1, opq_s(G), opq_s(bx));
                    EpiHead E{(bf16_t*)(ws + voff(gx, L_QRAW, 3072)), RowScale{slots2, 0, 3, 1.0f / 384}, a.in[I_QNOPEN] + 64, a.in[I_QROPEN] + 32, (const float*)(ws + WS_ROPE), (const float*)(ws + WS_ROPE) + (size_t)T * 16, QSCALE, 1536, 96}; gemm_phase<EpiHead, true>(lds, g, S, E, TIDV); } PHASE_END
            }
            PHASE_BEGIN(13) phase_attn(a, lds, TIDV, j); PHASE_END
            PHASE_BEGIN(14) { Gemm g{(const bf16_t*)(ws + voff(gx, L_O, 2048)), (const bf16_t*)(ws + WS_WO) + (size_t)j * DM * DM, DM, DM, DM, 0, 0}; Sched S; S.init(T, DM, 1, opq_s(G), opq_s(bx));
                EpiRes<false> E{a.out, xb, slots, false}; gemm_phase<EpiRes<false>, true>(lds, g, S, E, TIDV); } PHASE_END
        }
        PHASE_BEGIN(15) { Gemm g{xb, (const bf16_t*)(ws + WS_WGU) + (size_t)layer * 2 * FF * DM, DM, DM, DM, 0, 0}; Sched S; S.init(T, 2 * FF, 1, opq_s(G), opq_s(bx));
            EpiSwiGLU E{(bf16_t*)(ws + voff(gx, L_FFA, 5632)), RowScale{slots, 0, 8, 1.0f / DM}}; gemm_phase<EpiSwiGLU, true>(lds, g, S, E, TIDV); } PHASE_END
        PHASE_BEGIN(16) { Gemm g{(const bf16_t*)(ws + voff(gx, L_FFA, 5632)), (const bf16_t*)(ws + WS_WDN) + (size_t)layer * DM * FF, FF, FF, FF, 0, 0}; Sched S; S.init(T, DM, 1, opq_s(G), opq_s(bx));
            EpiRes<false> E{a.out, xb, slots, layer == 3}; gemm_phase<EpiRes<false>, true>(lds, g, S, E, TIDV); } PHASE_END_LAST(layer < 3)
    }
}

extern "C" void kernel_launch(void* const* d_in, const int* in_sizes, int n_in, void* d_out, int out_size, void* d_ws, size_t ws_size, hipStream_t stream) {
    static int grid = 0;
    if (grid == 0) {
        if (n_in != N_IN || out_size != T * DM || ws_size < WS_END) { fprintf(stderr, "kernel_launch: unexpected shapes (n_in %d out %d ws %zu)\n", n_in, out_size, ws_size); grid = -1; return; }
        int dev = 0, cus = 0, per = 0;
        (void)hipGetDevice(&dev); (void)hipDeviceGetAttribute(&cus, hipDeviceAttributeMultiprocessorCount, dev);
        (void)hipFuncSetAttribute((const void*)yoco_fwd, hipFuncAttributeMaxDynamicSharedMemorySize, LDS_BYTES);
        (void)hipOccupancyMaxActiveBlocksPerMultiprocessor(&per, (const void*)yoco_fwd, 512, LDS_BYTES);
        if (per < 1) per = 1;
        grid = cus * per;
        if (grid != 256) { fprintf(stderr, "kernel_launch: this build needs a 256-workgroup grid (8 groups of 32), got %d; nothing launched\n", grid); grid = -1; return; }
        fprintf(stderr, "kernel_launch: grid %d (cus %d x %d)\n", grid, cus, per);
    }
    if (grid < 0) return;
    (void)hipMemsetAsync((unsigned char*)d_ws + WS_BAR, 0, WS_BAR_BYTES, stream);
    Args a{};
    for (int i = 0; i < N_IN; ++i) a.in[i] = (const float*)d_in[i];
    a.out = (float*)d_out; a.ws = (unsigned char*)d_ws; a.ph_lo = 0; a.ph_hi = 1000;
    void* args[] = {&a};
    hipError_t e = hipLaunchCooperativeKernel((const void*)yoco_fwd, dim3(grid), dim3(512), args, LDS_BYTES, stream);
    if (e != hipSuccess) fprintf(stderr, "kernel_launch: cooperative launch failed: %s (grid %d)\n", hipGetErrorString(e), grid);
}
```
